# Optimizing an MI355X kernel written in HIP

```python
import math
import jax
import jax.numpy as jnp
from jax import lax
import numpy as np


D_MODEL = 1024
BATCH = 4
SEQ = 8192
DEPTH = 1
DEC_BATCH = 16
DEC_SEQ = 4096
PAST_LEN = 128

D_MIX = D_MODEL
DN_DK = 128
DN_DV = 128
DN_H = D_MIX // (2 * DN_DV)
DN_W = DN_H * DN_DV
DN_CHUNK = 64
SSM_P = 64
SSM_H = D_MIX // (2 * SSM_P)
SSM_W = SSM_H * SSM_P
SSM_G = 2
SSM_N = 128
SSM_CHUNK = 128
CONV_K = 5
D_FF = ((8 * D_MODEL + 3 * 256 - 1) // (3 * 256)) * 256
XBC_W = SSM_W + 2 * SSM_G * SSM_N
IN_SPLITS = (3 * DN_W, DN_W, 2 * DN_H, 2 * DN_H, SSM_W, XBC_W, 2 * SSM_H)
IN_COLS = 3 * DN_W + DN_W + 4 * DN_H + SSM_W + XBC_W + 2 * SSM_H
DEEPNORM_ALPHA = (2 * DEPTH) ** 0.25
DEEPNORM_BETA = (8 * DEPTH) ** -0.25
LN_EPS = 1e-5
RMS_EPS = 1e-6

kernel_name = 'hymba_deltanet_ssd_encoder'


def split_cols(t, sizes):
    out = []
    start = 0
    for s in sizes:
        out.append(t[..., start:start + s])
        start += s
    return out


def layer_norm(x, g, b):
    xf = x.astype(jnp.float32)
    mu = jnp.mean(xf, -1, keepdims=True)
    var = jnp.mean(jnp.square(xf - mu), -1, keepdims=True)
    return ((xf - mu) * lax.rsqrt(var + LN_EPS) * g + b).astype(x.dtype)


def rms_norm(x):
    xf = x.astype(jnp.float32)
    return xf * lax.rsqrt(jnp.mean(jnp.square(xf), -1, keepdims=True) + RMS_EPS)


def l2norm(x):
    return x * lax.rsqrt(jnp.sum(jnp.square(x), -1, keepdims=True) + RMS_EPS)


def centred_dwconv(u, w):
    K = w.shape[0]
    pad = K // 2
    T = u.shape[1]
    up = jnp.pad(u, ((0, 0), (pad, pad), (0, 0)))
    return sum(up[:, i:i + T] * w[i] for i in range(K))


def flip_t(t):
    return jnp.flip(t, axis=1)


def gated_delta_chunked(q, k, v, g, beta):
    f32 = jnp.float32
    Bsz, T, H, Dk = q.shape
    Dv = v.shape[-1]
    C = DN_CHUNK
    N = T // C

    def blocks(t):
        t = t.astype(f32).reshape((Bsz, N, C) + t.shape[2:])
        return jnp.moveaxis(t, 3, 2)

    q = blocks(q) * (Dk ** -0.5)
    k, v, g, beta = blocks(k), blocks(v), blocks(g), blocks(beta)
    g = jnp.cumsum(g, axis=-1)
    incl = jnp.tril(jnp.ones((C, C), bool))
    strict = jnp.tril(jnp.ones((C, C), bool), -1)
    decay = jnp.exp(jnp.where(incl, g[..., :, None] - g[..., None, :], -jnp.inf))
    k_beta = k * beta[..., None]
    L = jnp.where(strict, jnp.einsum('bnhid,bnhjd->bnhij', k_beta, k) * decay, 0.0)
    rhs = jnp.concatenate([k_beta * jnp.exp(g)[..., None], v * beta[..., None]], -1)
    wu = lax.linalg.triangular_solve(L, rhs, left_side=True, lower=True, unit_diagonal=True)
    w, u = wu[..., :Dk], wu[..., Dk:]
    attn = jnp.einsum('bnhid,bnhjd->bnhij', q, k) * decay
    q_dec = q * jnp.exp(g)[..., None]
    g_last = g[..., -1]
    k_dec = k * jnp.exp(g_last[..., None] - g)[..., None]

    def step(S, xs):
        q_c, k_c, w_c, u_c, a_c, gl_c = xs
        v_new = u_c - jnp.einsum('bhcd,bhde->bhce', w_c, S)
        o = jnp.einsum('bhcd,bhde->bhce', q_c, S) + jnp.einsum('bhij,bhje->bhie', a_c, v_new)
        S = S * jnp.exp(gl_c)[..., None, None] + jnp.einsum('bhcd,bhce->bhde', k_c, v_new)
        return S, o

    xs = tuple(jnp.moveaxis(t, 1, 0) for t in (q_dec, k_dec, w, u, attn, g_last))
    S0 = jnp.zeros((Bsz, H, Dk, Dv), f32)
    _, o = lax.scan(step, S0, xs)
    o = jnp.moveaxis(o, 0, 1)
    return jnp.moveaxis(o, 2, 3).reshape(Bsz, T, H, Dv)


def ssd_chunked(x, dt, A, Bm, Cm):
    f32 = jnp.float32
    Bsz, T, H, P = x.shape
    G, N = Bm.shape[2], Bm.shape[3]
    R = H // G
    Lc = SSM_CHUNK
    Nc = T // Lc
    x = x.astype(f32).reshape(Bsz, Nc, Lc, G, R, P)
    dt = dt.astype(f32).reshape(Bsz, Nc, Lc, G, R)
    Bm = Bm.astype(f32).reshape(Bsz, Nc, Lc, G, N)
    Cm = Cm.astype(f32).reshape(Bsz, Nc, Lc, G, N)
    a = jnp.transpose(dt * A.reshape(G, R), (0, 3, 4, 1, 2))
    a_cs = jnp.cumsum(a, -1)
    xdt = x * dt[..., None]
    incl = jnp.tril(jnp.ones((Lc, Lc), bool))
    Lmat = jnp.exp(jnp.where(incl, a_cs[..., :, None] - a_cs[..., None, :], -jnp.inf))
    CB = jnp.einsum('bclgn,bcsgn->bgcls', Cm, Bm)
    y_diag = jnp.einsum('bgrcls,bcsgrp->bclgrp', CB[:, :, None] * Lmat, xdt)
    decay_states = jnp.exp(a_cs[..., -1:] - a_cs)
    states = jnp.einsum('bclgn,bgrcl,bclgrp->cbgrpn', Bm, decay_states, xdt)
    chunk_decay = jnp.moveaxis(jnp.exp(a_cs[..., -1]), 3, 0)

    def step(S, inp):
        st, dec = inp
        return S * dec[..., None, None] + st, S

    S0 = jnp.zeros((Bsz, G, R, P, N), f32)
    _, S_prev = lax.scan(step, S0, (states, chunk_decay))
    y_off = jnp.einsum('bclgn,cbgrpn,bgrcl->bclgrp', Cm, S_prev, jnp.exp(a_cs))
    return (y_diag + y_off).reshape(Bsz, T, H, P)


def gated_deltanet_mixer(qkv, z, a, b, conv_w, A_log, dt_bias, norm_w):
    f32 = jnp.float32
    Bsz, T, _ = qkv.shape
    qkv = jax.nn.silu(centred_dwconv(qkv.astype(f32), conv_w.astype(f32)))
    q, k, v = jnp.split(qkv, 3, axis=-1)
    q = l2norm(q.reshape(Bsz, T, DN_H, DN_DK))
    k = l2norm(k.reshape(Bsz, T, DN_H, DN_DK))
    v = v.reshape(Bsz, T, DN_H, DN_DV)
    a = a.astype(f32).reshape(Bsz, T, 2, DN_H)
    b = b.astype(f32).reshape(Bsz, T, 2, DN_H)
    g = -jnp.exp(A_log.astype(f32)) * jax.nn.softplus(a + dt_bias.astype(f32))
    beta = jax.nn.sigmoid(b)
    o_f = gated_delta_chunked(q, k, v, g[:, :, 0], beta[:, :, 0])
    o_b = flip_t(gated_delta_chunked(flip_t(q), flip_t(k), flip_t(v),
                                     flip_t(g[:, :, 1]), flip_t(beta[:, :, 1])))
    zf = z.astype(f32).reshape(Bsz, T, DN_H, DN_DV)
    o = rms_norm(o_f + o_b) * norm_w * jax.nn.silu(zf)
    return o.reshape(Bsz, T, DN_W).astype(z.dtype)


def mamba2_ssd_mixer(z, xbc, dt_raw, conv_w, conv_b, A_log, dt_bias, D, norm_w):
    f32 = jnp.float32
    Bsz, T, _ = xbc.shape
    xbc = jax.nn.silu(centred_dwconv(xbc.astype(f32), conv_w.astype(f32)) + conv_b)
    xs, Bm, Cm = split_cols(xbc, (SSM_W, SSM_G * SSM_N, SSM_G * SSM_N))
    xs = xs.reshape(Bsz, T, SSM_H, SSM_P)
    Bm = Bm.reshape(Bsz, T, SSM_G, SSM_N)
    Cm = Cm.reshape(Bsz, T, SSM_G, SSM_N)
    dt = jax.nn.softplus(dt_raw.astype(f32).reshape(Bsz, T, 2, SSM_H) + dt_bias.astype(f32))
    A = -jnp.exp(A_log.astype(f32))
    y_f = ssd_chunked(xs, dt[:, :, 0], A[0], Bm, Cm)
    y_b = flip_t(ssd_chunked(flip_t(xs), flip_t(dt[:, :, 1]), A[1], flip_t(Bm), flip_t(Cm)))
    y = y_f + y_b + D[:, None] * xs
    y = y.reshape(Bsz, T, SSM_G, SSM_W // SSM_G) * jax.nn.silu(
        z.astype(f32).reshape(Bsz, T, SSM_G, SSM_W // SSM_G))
    y = rms_norm(y) * norm_w.reshape(SSM_G, SSM_W // SSM_G)
    return y.reshape(Bsz, T, SSM_W).astype(z.dtype)


def encoder_layer(x, c, w_ada, b_ada, w_in, dn_conv_w, dn_A_log, dn_dt_bias, dn_norm_w,
                  ssm_conv_w, ssm_conv_b, ssm_A_log, ssm_dt_bias, ssm_D, ssm_norm_w,
                  w_out, ln1_g, ln1_b, w_gate, w_up, w_down, ln2_g, ln2_b):
    mod = jax.nn.silu(c) @ w_ada + b_ada
    sh1, sc1, gt1, sh2, sc2, gt2 = jnp.split(mod[:, None, :], 6, axis=-1)
    h = x * (1 + sc1) + sh1
    proj = h @ w_in
    dn_qkv, dn_z, dn_a, dn_b, ssm_z, ssm_xbc, ssm_dt = split_cols(proj, IN_SPLITS)
    o_dn = gated_deltanet_mixer(dn_qkv, dn_z, dn_a, dn_b, dn_conv_w, dn_A_log, dn_dt_bias, dn_norm_w)
    o_ssm = mamba2_ssd_mixer(ssm_z, ssm_xbc, ssm_dt, ssm_conv_w, ssm_conv_b, ssm_A_log,
                             ssm_dt_bias, ssm_D, ssm_norm_w)
    mix = jnp.concatenate([o_dn, o_ssm], -1) @ w_out
    x = layer_norm(DEEPNORM_ALPHA * x + gt1 * mix, ln1_g, ln1_b)
    h = x * (1 + sc2) + sh2
    ffn = (jax.nn.silu(h @ w_gate) * (h @ w_up)) @ w_down
    return layer_norm(DEEPNORM_ALPHA * x + gt2 * ffn, ln2_g, ln2_b)


def setup_inputs(seed: int = 0) -> dict:
    key = jax.random.key(seed)
    ks = jax.random.split(key, 32)
    f32 = jnp.float32

    def nrm(k, shape, s):
        return jax.random.normal(k, shape, f32) * s

    def dt_bias_init(k, shape):
        dt0 = jnp.exp(jax.random.uniform(k, shape, f32, math.log(1e-3), math.log(1e-1)))
        return dt0 + jnp.log(-jnp.expm1(-dt0))

    def a_log_init(k, shape):
        return jnp.log(jax.random.uniform(k, shape, f32, 1.0, 16.0))

    return {
        'x_prompt': nrm(ks[0], (BATCH, SEQ, D_MODEL), 1.0),
        'x_sample': nrm(ks[1], (DEC_BATCH, DEC_SEQ, D_MODEL), 1.0),
        'c_prompt': nrm(ks[2], (BATCH, D_MODEL), 1.0),
        'c_sample': nrm(ks[3], (DEC_BATCH, D_MODEL), 1.0),
        'w_ada': nrm(ks[4], (DEPTH, D_MODEL, 6 * D_MODEL), D_MODEL ** -0.5),
        'b_ada': nrm(ks[5], (DEPTH, 6 * D_MODEL), 0.02),
        'w_in': nrm(ks[6], (DEPTH, D_MODEL, IN_COLS), D_MODEL ** -0.5),
        'dn_conv_w': nrm(ks[7], (DEPTH, CONV_K, 3 * DN_W), CONV_K ** -0.5),
        'dn_A_log': a_log_init(ks[8], (DEPTH, 2, DN_H)),
        'dn_dt_bias': dt_bias_init(ks[9], (DEPTH, 2, DN_H)),
        'dn_norm_w': 1.0 + nrm(ks[10], (DEPTH, DN_DV), 0.02),
        'ssm_conv_w': nrm(ks[11], (DEPTH, CONV_K, XBC_W), CONV_K ** -0.5),
        'ssm_conv_b': nrm(ks[12], (DEPTH, XBC_W), 0.02),
        'ssm_A_log': a_log_init(ks[13], (DEPTH, 2, SSM_H)),
        'ssm_dt_bias': dt_bias_init(ks[14], (DEPTH, 2, SSM_H)),
        'ssm_D': 1.0 + nrm(ks[15], (DEPTH, SSM_H), 0.02),
        'ssm_norm_w': 1.0 + nrm(ks[16], (DEPTH, SSM_W), 0.02),
        'w_out': nrm(ks[17], (DEPTH, D_MIX, D_MODEL), DEEPNORM_BETA * D_MIX ** -0.5),
        'ln1_g': 1.0 + nrm(ks[18], (DEPTH, D_MODEL), 0.02),
        'ln1_b': nrm(ks[19], (DEPTH, D_MODEL), 0.02),
        'w_gate': nrm(ks[20], (DEPTH, D_MODEL, D_FF), D_MODEL ** -0.5),
        'w_up': nrm(ks[21], (DEPTH, D_MODEL, D_FF), D_MODEL ** -0.5),
        'w_down': nrm(ks[22], (DEPTH, D_FF, D_MODEL), DEEPNORM_BETA * D_FF ** -0.5),
        'ln2_g': 1.0 + nrm(ks[23], (DEPTH, D_MODEL), 0.02),
        'ln2_b': nrm(ks[24], (DEPTH, D_MODEL), 0.02),
    }


def reference(x_prompt, x_sample, c_prompt, c_sample, w_ada, b_ada, w_in, dn_conv_w, dn_A_log,
              dn_dt_bias, dn_norm_w, ssm_conv_w, ssm_conv_b, ssm_A_log, ssm_dt_bias, ssm_D,
              ssm_norm_w, w_out, ln1_g, ln1_b, w_gate, w_up, w_down, ln2_g, ln2_b):
    params = (w_ada, b_ada, w_in, dn_conv_w, dn_A_log, dn_dt_bias, dn_norm_w, ssm_conv_w,
              ssm_conv_b, ssm_A_log, ssm_dt_bias, ssm_D, ssm_norm_w, w_out, ln1_g, ln1_b,
              w_gate, w_up, w_down, ln2_g, ln2_b)

    def run(x, c):
        for l in range(DEPTH):
            x = encoder_layer(x, c, *[p[l] for p in params])
        return x

    y_prompt = run(x_prompt, c_prompt)
    y_sample = run(x_sample, c_sample)
    return (y_prompt, y_sample)
```

```cpp
#include <hip/hip_runtime.h>
#include <hip/hip_cooperative_groups.h>
#include <cstdio>

namespace cg = cooperative_groups;

#define LAS __attribute__((address_space(3)))
typedef unsigned short u16;
typedef short bf16x8 __attribute__((ext_vector_type(8)));
typedef float f32x4 __attribute__((ext_vector_type(4)));
typedef unsigned u32x4 __attribute__((ext_vector_type(4)));
typedef unsigned u32x2 __attribute__((ext_vector_type(2)));

constexpr int NTOK = 98304;
constexpr size_t U = (size_t)NTOK * 512 * 2;
constexpr size_t OFF_MISC = 10 * U;
constexpr size_t OFF_WB1 = OFF_MISC;
constexpr size_t OFF_WB2 = OFF_WB1 + (size_t)3840 * 1024 * 2;
constexpr size_t OFF_WB3 = OFF_WB2 + (size_t)1024 * 1024 * 2;
constexpr size_t OFF_WB4 = OFF_WB3 + (size_t)5632 * 1024 * 2;
constexpr size_t OFF_SMALL = OFF_WB4 + (size_t)1024 * 2816 * 2;
constexpr size_t OFF_MOD = OFF_SMALL + (size_t)NTOK * 32 * 4;
constexpr size_t OFF_GCUM = OFF_MOD + (size_t)20 * 6144 * 4;
constexpr size_t OFF_CNT = OFF_GCUM + (size_t)12288 * 128 * 4;
constexpr size_t WS_END = OFF_CNT + 256;
constexpr int LDS_BYTES = 147456;
constexpr float ALPHA = 1.189207115002721f;

struct P {
    const float *x_prompt, *x_sample, *c_prompt, *c_sample, *w_ada, *b_ada, *w_in, *dn_conv_w, *dn_A_log, *dn_dt_bias, *dn_norm_w,
        *ssm_conv_w, *ssm_conv_b, *ssm_A_log, *ssm_dt_bias, *ssm_D, *ssm_norm_w, *w_out, *ln1_g, *ln1_b, *w_gate, *w_up, *w_down, *ln2_g, *ln2_b;
    float* out; unsigned char* ws;
};

typedef __bf16 bf16v2 __attribute__((ext_vector_type(2)));
typedef float f32x2 __attribute__((ext_vector_type(2)));
__device__ __forceinline__ unsigned pk(float lo, float hi) { f32x2 v; v.x = lo; v.y = hi; bf16v2 b = __builtin_convertvector(v, bf16v2); return __builtin_bit_cast(unsigned, b); }
__device__ __forceinline__ u16 f2bf(float f) { return (u16)pk(f, f); }
__device__ __forceinline__ float bf2f(u16 b) { return __uint_as_float(((unsigned)b) << 16); }
__device__ __forceinline__ float blo(unsigned w) { return __uint_as_float(w << 16); }
__device__ __forceinline__ float bhi(unsigned w) { return __uint_as_float(w & 0xffff0000u); }
__device__ __forceinline__ float silu_f(float x) { return x * __builtin_amdgcn_rcpf(1.f + __expf(-x)); }
__device__ __forceinline__ float softplus_f(float x) { const float e = __expf(x); return x > 20.f ? x : (e < 1e-3f ? e * (1.f - 0.5f * e) : __logf(1.f + e)); }
__device__ __forceinline__ unsigned sw16(unsigned w) { return (w >> 16) | (w << 16); }
__device__ __forceinline__ u32x4 rev8(u32x4 v) { u32x4 o; o.x = sw16(v.w); o.y = sw16(v.z); o.z = sw16(v.y); o.w = sw16(v.x); return o; }
__device__ __forceinline__ bf16x8 asbf(u32x4 v) { return __builtin_bit_cast(bf16x8, v); }
__device__ __forceinline__ f32x4 mfma16(bf16x8 a, bf16x8 b, f32x4 c) { return __builtin_amdgcn_mfma_f32_16x16x32_bf16(a, b, c, 0, 0, 0); }
__device__ __forceinline__ void seq_info(int s, int& T, int& row0) { if (s < 4) { T = 8192; row0 = s * 8192; } else { T = 4096; row0 = 32768 + (s - 4) * 4096; } }
__device__ __forceinline__ int seq_of_row(int R) { return R < 32768 ? (R >> 13) : 4 + ((R - 32768) >> 12); }
__device__ __forceinline__ bf16x8 ldA2(const u16* p) { u32x2 lo = *(const u32x2*)p, hi = *(const u32x2*)(p + 16); u32x4 v; v.x = lo.x; v.y = lo.y; v.z = hi.x; v.w = hi.y; return asbf(v); }
__device__ __forceinline__ bf16x8 packB(f32x4 a, f32x4 b) { u32x4 v; v.x = pk(a[0], a[1]); v.y = pk(a[2], a[3]); v.z = pk(b[0], b[1]); v.w = pk(b[2], b[3]); return asbf(v); }

namespace pg8 {
constexpr int BM = 256, BK = 64, HALF = 128, HTB = HALF * BK * 2, STAGE_BYTES = 8 * HTB, NXCD = 8, WGM = 8;
__host__ __device__ __forceinline__ int lds_byte(int r, int c) { const int st = (r >> 4) * 2 + (c >> 5), rr = r & 15, cc = c & 31, ob = rr * 64 + cc * 2; return st * 1024 + (ob ^ (((ob >> 9) & 1) << 5)); }
__host__ __device__ __forceinline__ void stage_rc(int b, int& R, int& C) { const int st = b / 1024, sb = b % 1024, swz = sb ^ (((sb >> 9) & 1) << 5); R = (st >> 1) * 16 + swz / 64; C = (st & 1) * 32 + (swz % 64) / 2; }
__host__ __device__ __forceinline__ int perm32(int rho) { const int n = rho >> 4, i = rho & 15; return 8 * (i >> 2) + 4 * n + (i & 3); }
struct Unit { int pm, pn; };
struct Gemm { const u16* A; const u16* Bt; int M, N, K; };
struct StaticOrder {
    int nM, nN, nwg, G, c;
    __device__ void init(int M, int N, int G_, int c_) { nM = M / BM; nN = N / BM; nwg = nM * nN; G = G_; c = c_; }
    __device__ bool next(int i, Unit& u) const {
        const long L = (long)i * G + c; if (L >= nwg) return false;
        int wgid = (int)L; { const int q = nwg / NXCD, r = nwg % NXCD, xcd = wgid % NXCD, off = wgid / NXCD; wgid = (xcd < r ? xcd * (q + 1) : r * (q + 1) + (xcd - r) * q) + off; }
        const int nig = WGM * nN, gid = wgid / nig, fm = gid * WGM, gsz = (nM - fm) < WGM ? (nM - fm) : WGM;
        u.pm = fm + ((wgid % nig) % gsz); u.pn = (wgid % nig) / gsz; return true;
    }
    __device__ __forceinline__ void a_ready(const Unit&) const {}
    __device__ __forceinline__ void done(const Unit&) const {}
};

template <class Epi, class Sched>
__device__ __forceinline__ void gemm_phase(LAS unsigned char* lds, const Gemm g, const Sched& S, const Epi& E) {
    const int tid = threadIdx.x, wid = __builtin_amdgcn_readfirstlane(tid >> 6), lane = tid & 63, wr = wid >> 2, wc = wid & 3, fr = lane & 15, fq = lane >> 4;
    const int K = g.K, nt = K / BK;
    unsigned voffA[2], voffB[2];
#pragma unroll
    for (int i = 0; i < 2; ++i) { int R, C; stage_rc(tid * 16 + i * 8192, R, C); const int Rb = Epi::PERM ? ((R & ~31) + perm32(R & 31)) : R;
        voffA[i] = (unsigned)(R * K + C) * 2u; voffB[i] = (unsigned)(Rb * K + C) * 2u; }
    const size_t kstep = (size_t)(BK * 2);
    const size_t hstep = (size_t)HALF * K * 2;
    const size_t tstep = 2 * hstep;
    const unsigned ldsw = (unsigned)wid * 1024u;
    const int aoff = lds_byte(wr * 64 + fr, fq * 8), boff = lds_byte(wc * 32 + fr, fq * 8);
#define PG8_SA(b, h) (((b) * 2 + (h)) * HTB)
#define PG8_SB(b, h) ((4 + (b) * 2 + (h)) * HTB)
#define PG8_STAGE(bufoff, gbase, voff) do { _Pragma("unroll") for (int _i = 0; _i < 2; ++_i) \
        __builtin_amdgcn_global_load_lds((const unsigned*)((const char*)(gbase) + (voff)[_i]), (LAS unsigned*)(lds + (bufoff) + ldsw + _i * 8192), 16, 0, 0); } while (0)
#define PG8_LDA(dst, b, h) do { _Pragma("unroll") for (int m = 0; m < 4; ++m) _Pragma("unroll") for (int k = 0; k < 2; ++k) dst[m][k] = *(const LAS bf16x8*)(lds + PG8_SA(b, h) + aoff + m * 2048 + k * 1024); } while (0)
#define PG8_LDB(dst, b, h) do { _Pragma("unroll") for (int n = 0; n < 2; ++n) _Pragma("unroll") for (int k = 0; k < 2; ++k) dst[n][k] = *(const LAS bf16x8*)(lds + PG8_SB(b, h) + boff + n * 2048 + k * 1024); } while (0)
#define PG8_MMA(ai, bj, At, Bt) do { __builtin_amdgcn_s_setprio(1); _Pragma("unroll") for (int m = 0; m < 4; ++m) _Pragma("unroll") for (int n = 0; n < 2; ++n) _Pragma("unroll") for (int k = 0; k < 2; ++k) \
        acc[ai][bj][m][n] = __builtin_amdgcn_mfma_f32_16x16x32_bf16(Bt[n][k], At[m][k], acc[ai][bj][m][n], 0, 0, 0); __builtin_amdgcn_s_setprio(0); } while (0)
#define PG8_WAIT_V(n) asm volatile("s_waitcnt vmcnt(" #n ")" ::: "memory")
#define PG8_WAIT_L(n) asm volatile("s_waitcnt lgkmcnt(" #n ")" ::: "memory")
#define PG8_BAR __builtin_amdgcn_s_barrier()
#define PG8_SCHED __builtin_amdgcn_sched_barrier(0)
    Unit cur, nxt; int ui = 0;
    if (!S.next(0, cur)) return;
    f32x4 acc[2][2][4][2];
#pragma unroll
    for (int a = 0; a < 2; ++a)
#pragma unroll
        for (int b = 0; b < 2; ++b)
#pragma unroll
            for (int m = 0; m < 4; ++m)
#pragma unroll
                for (int n = 0; n < 2; ++n) acc[a][b][m][n] = (f32x4){0.f, 0.f, 0.f, 0.f};
    bf16x8 At[4][2], B0[2][2], B1[2][2];
    const char* cA = (const char*)g.A + (size_t)cur.pm * tstep; const char* cB = (const char*)g.Bt + (size_t)cur.pn * tstep;
    S.a_ready(cur);
    PG8_STAGE(PG8_SB(0, 0), cB, voffB); PG8_STAGE(PG8_SA(0, 0), cA, voffA); PG8_STAGE(PG8_SB(0, 1), cB + hstep, voffB); PG8_STAGE(PG8_SA(0, 1), cA + hstep, voffA);
    if (wr == 1) PG8_BAR;
    PG8_WAIT_V(4); PG8_BAR;
    PG8_STAGE(PG8_SB(1, 0), cB + kstep, voffB); PG8_STAGE(PG8_SA(1, 0), cA + kstep, voffA); PG8_STAGE(PG8_SB(1, 1), cB + hstep + kstep, voffB);
    PG8_WAIT_V(6); PG8_BAR;
    for (;;) {
        const bool has_next = S.next(ui + 1, nxt);
        const char* nA = has_next ? (const char*)g.A + (size_t)nxt.pm * tstep : cA; const char* nB = has_next ? (const char*)g.Bt + (size_t)nxt.pn * tstep : cB;
        for (int t = 0; t < nt; t += 2) {
            const bool last = (t == nt - 2);
            const char* a1 = cA + (size_t)(t + 1) * kstep;
            const char* a2 = last ? nA : cA + (size_t)(t + 2) * kstep; const char* b2 = last ? nB : cB + (size_t)(t + 2) * kstep;
            const char* a3 = a2 + kstep; const char* b3 = b2 + kstep;
            if (last && has_next) S.a_ready(nxt);
            PG8_LDB(B0, 0, 0); PG8_SCHED; PG8_LDA(At, 0, 0); PG8_STAGE(PG8_SA(1, 1), a1 + hstep, voffA);
            PG8_WAIT_L(8); PG8_BAR; PG8_WAIT_L(0); PG8_MMA(0, 0, At, B0); PG8_BAR; PG8_SCHED;
            PG8_LDB(B1, 0, 1); PG8_STAGE(PG8_SB(0, 0), b2, voffB);
            PG8_BAR; PG8_WAIT_L(0); PG8_MMA(0, 1, At, B1); PG8_BAR;
            PG8_LDA(At, 0, 1); PG8_STAGE(PG8_SA(0, 0), a2, voffA);
            PG8_BAR; PG8_WAIT_L(0); PG8_MMA(1, 0, At, B0); PG8_BAR; PG8_SCHED;
            PG8_STAGE(PG8_SB(0, 1), b2 + hstep, voffB);
            PG8_WAIT_V(6); PG8_BAR; PG8_MMA(1, 1, At, B1); PG8_BAR;
            PG8_LDB(B0, 1, 0); PG8_SCHED; PG8_LDA(At, 1, 0); PG8_STAGE(PG8_SA(0, 1), a2 + hstep, voffA);
            PG8_WAIT_L(8); PG8_BAR; PG8_WAIT_L(0); PG8_MMA(0, 0, At, B0); PG8_BAR; PG8_SCHED;
            PG8_LDB(B1, 1, 1); PG8_STAGE(PG8_SB(1, 0), b3, voffB);
            PG8_BAR; PG8_WAIT_L(0); PG8_MMA(0, 1, At, B1); PG8_BAR;
            PG8_LDA(At, 1, 1); PG8_STAGE(PG8_SA(1, 0), a3, voffA);
            PG8_BAR; PG8_WAIT_L(0); PG8_MMA(1, 0, At, B0); PG8_BAR; PG8_SCHED;
            PG8_STAGE(PG8_SB(1, 1), b3 + hstep, voffB);
            PG8_WAIT_V(6); PG8_BAR; PG8_MMA(1, 1, At, B1); PG8_BAR;
        }
        E(acc, cur, wr, wc, fr, fq); S.done(cur);
        if (!has_next) break;
#pragma unroll
        for (int a = 0; a < 2; ++a)
#pragma unroll
            for (int b = 0; b < 2; ++b)
#pragma unroll
                for (int m = 0; m < 4; ++m)
#pragma unroll
                    for (int n = 0; n < 2; ++n) acc[a][b][m][n] = (f32x4){0.f, 0.f, 0.f, 0.f};
        cur = nxt; cA = nA; cB = nB; ++ui;
    }
    PG8_WAIT_V(0);
    if (wr == 0) PG8_BAR;
    PG8_BAR;
#undef PG8_SA
#undef PG8_SB
#undef PG8_STAGE
#undef PG8_LDA
#undef PG8_LDB
#undef PG8_MMA
#undef PG8_WAIT_V
#undef PG8_WAIT_L
#undef PG8_BAR
#undef PG8_SCHED
}
}

struct EpiIn {
    static constexpr bool PERM = true;
    u16 *qkv, *dnz, *ssmz, *xbc; float* small;
    __device__ __forceinline__ void operator()(const f32x4 (&acc)[2][2][4][2], const pg8::Unit& u, int wr, int wc, int fr, int fq) const {
        const int row0 = u.pm * 256 + wr * 64 + fr; const int pn = u.pn;
        if (pn < 14) {
            u16* base; int ld, colt;
            if (pn < 6) { base = qkv; ld = 1536; colt = pn * 256; }
            else if (pn < 8) { base = dnz; ld = 512; colt = (pn - 6) * 256; }
            else if (pn < 10) { base = ssmz; ld = 512; colt = (pn - 8) * 256; }
            else { base = xbc; ld = 1024; colt = (pn - 10) * 256; }
            const int col0 = colt + wc * 32 + 8 * fq;
#pragma unroll
            for (int ai = 0; ai < 2; ++ai)
#pragma unroll
                for (int m = 0; m < 4; ++m) { u16* rowp = base + (size_t)(row0 + ai * 128 + m * 16) * ld + col0;
#pragma unroll
                    for (int bj = 0; bj < 2; ++bj) { const f32x4 v0 = acc[ai][bj][m][0], v1 = acc[ai][bj][m][1];
                        u32x4 w; w.x = pk(v0[0], v0[1]); w.y = pk(v0[2], v0[3]); w.z = pk(v1[0], v1[1]); w.w = pk(v1[2], v1[3]);
                        *(u32x4*)(rowp + bj * 128) = w; } }
        } else if (wc == 0) {
#pragma unroll
            for (int ai = 0; ai < 2; ++ai)
#pragma unroll
                for (int m = 0; m < 4; ++m) { float* rp = small + (size_t)(row0 + ai * 128 + m * 16) * 32 + 8 * fq;
                    *(f32x4*)rp = acc[ai][0][m][0]; *(f32x4*)(rp + 4) = acc[ai][0][m][1]; }
        }
    }
};
template <bool BF, bool XBF> struct EpiResT {
    static constexpr bool PERM = false;
    const float* xp; const float* xs; const u16* xb; float* out; u16* outb; const float* gate;
    __device__ __forceinline__ void operator()(const f32x4 (&acc)[2][2][4][2], const pg8::Unit& u, int wr, int wc, int fr, int fq) const {
        const int rowt = u.pm * 256; const int s = seq_of_row(rowt); const float* g = gate + s * 6144;
        const int row0 = rowt + wr * 64 + fr, col0 = u.pn * 256 + wc * 32 + 4 * fq;
        f32x4 gv[2][2];
#pragma unroll
        for (int bj = 0; bj < 2; ++bj)
#pragma unroll
            for (int n = 0; n < 2; ++n) gv[bj][n] = *(const f32x4*)(g + col0 + bj * 128 + n * 16);
#pragma unroll
        for (int ai = 0; ai < 2; ++ai)
#pragma unroll
            for (int m = 0; m < 4; ++m) { const int R = row0 + ai * 128 + m * 16;
                const float* xr = (R < 32768 ? xp + (size_t)R * 1024 : xs + (size_t)(R - 32768) * 1024) + col0;
#pragma unroll
                for (int bj = 0; bj < 2; ++bj)
#pragma unroll
                    for (int n = 0; n < 2; ++n) { f32x4 xv; if (XBF) { const u32x2 xw = *(const u32x2*)(xb + (size_t)R * 1024 + col0 + bj * 128 + n * 16); xv[0] = blo(xw.x); xv[1] = bhi(xw.x); xv[2] = blo(xw.y); xv[3] = bhi(xw.y); } else xv = *(const f32x4*)(xr + bj * 128 + n * 16);
                        const f32x4 y = ALPHA * xv + gv[bj][n] * acc[ai][bj][m][n];
                        if (BF) { u32x2 w; w.x = pk(y[0], y[1]); w.y = pk(y[2], y[3]); *(u32x2*)(outb + (size_t)R * 1024 + col0 + bj * 128 + n * 16) = w; }
                        else *(f32x4*)(out + (size_t)R * 1024 + col0 + bj * 128 + n * 16) = y; }
                asm volatile("" ::: "memory"); }
    }
};
struct EpiGLU {
    static constexpr bool PERM = true;
    u16* act;
    __device__ __forceinline__ void operator()(const f32x4 (&acc)[2][2][4][2], const pg8::Unit& u, int wr, int wc, int fr, int fq) const {
        const int row0 = u.pm * 256 + wr * 64 + fr, ff0 = u.pn * 128 + wc * 32 + 8 * fq;
#pragma unroll
        for (int ai = 0; ai < 2; ++ai)
#pragma unroll
            for (int m = 0; m < 4; ++m) { u16* rp = act + (size_t)(row0 + ai * 128 + m * 16) * 2816 + ff0; float v[8];
#pragma unroll
                for (int n = 0; n < 2; ++n) { const f32x4 gt = acc[ai][0][m][n], up = acc[ai][1][m][n];
#pragma unroll
                    for (int j = 0; j < 4; ++j) v[n * 4 + j] = silu_f(gt[j]) * up[j]; }
                u32x4 w; w.x = pk(v[0], v[1]); w.y = pk(v[2], v[3]); w.z = pk(v[4], v[5]); w.w = pk(v[6], v[7]); *(u32x4*)rp = w; }
    }
};

__device__ __forceinline__ int map_in_col(int n) { if (n < 2048) return n; if (n < 3584) return n + 16; if (n < 3600) return 2048 + (n - 3584); if (n < 3616) return n; return -1; }
__device__ void weight_tile(const P& p, unsigned char* lds, int t) {
    const int tid = threadIdx.x; float* tile = (float*)lds;
    int which, nt, kt, K; u16* dst;
    if (t < 960) { which = 1; nt = t / 16; kt = t % 16; K = 1024; dst = (u16*)(p.ws + OFF_WB1); }
    else if (t < 1216) { which = 2; nt = (t - 960) / 16; kt = (t - 960) % 16; K = 1024; dst = (u16*)(p.ws + OFF_WB2); }
    else if (t < 2624) { which = 3; nt = (t - 1216) / 16; kt = (t - 1216) % 16; K = 1024; dst = (u16*)(p.ws + OFF_WB3); }
    else { which = 4; nt = (t - 2624) / 44; kt = (t - 2624) % 44; K = 2816; dst = (u16*)(p.ws + OFF_WB4); }
    const int n0 = nt * 64, k0 = kt * 64;
    for (int e = tid; e < 4096; e += 512) { const int kk = e >> 6, nn = e & 63, n = n0 + nn; const size_t k = (size_t)(k0 + kk); float v;
        if (which == 1) { const int col = map_in_col(n); v = col >= 0 ? p.w_in[k * 3616 + col] : 0.f; }
        else if (which == 2) v = p.w_out[k * 1024 + n];
        else if (which == 3) { const int ff = (n >> 8) * 128 + (n & 127); v = ((n >> 7) & 1) ? p.w_up[k * 2816 + ff] : p.w_gate[k * 2816 + ff]; }
        else v = p.w_down[k * 1024 + n];
        tile[kk * 65 + nn] = v; }
    __syncthreads();
    for (int e = tid; e < 4096; e += 512) { const int nn = e >> 6, kk = e & 63; dst[(size_t)(n0 + nn) * K + k0 + kk] = f2bf(tile[kk * 65 + nn]); }
    __syncthreads();
}
__device__ void phase_prep(const P& p, unsigned char* lds) {
    const int tid = threadIdx.x;
    float* fl = (float*)lds;
    if (blockIdx.x == 0 && tid < 64) ((unsigned*)(p.ws + OFF_CNT))[tid] = 0u;
    float* mod = (float*)(p.ws + OFF_MOD);
    if (blockIdx.x < 96) {
        float* sc = fl; float* red = fl + 20 * 1024;
        for (int e = tid; e < 20 * 1024; e += 512) { const int b = e >> 10, k = e & 1023; const float c = b < 4 ? p.c_prompt[b * 1024 + k] : p.c_sample[(b - 4) * 1024 + k]; sc[e] = silu_f(c); }
        __syncthreads();
        const int kg = tid >> 6, jj = tid & 63, j = blockIdx.x * 64 + jj;
        float acc[20];
#pragma unroll
        for (int b = 0; b < 20; ++b) acc[b] = 0.f;
        for (int k = kg * 128; k < kg * 128 + 128; ++k) { const float wv = p.w_ada[(size_t)k * 6144 + j];
#pragma unroll
            for (int b = 0; b < 20; ++b) acc[b] += sc[b * 1024 + k] * wv; }
#pragma unroll
        for (int b = 0; b < 20; ++b) red[(kg * 20 + b) * 64 + jj] = acc[b];
        __syncthreads();
        for (int e = tid; e < 1280; e += 512) { const int b = e >> 6, j2 = e & 63; float s = p.b_ada[blockIdx.x * 64 + j2];
#pragma unroll
            for (int k2 = 0; k2 < 8; ++k2) s += red[(k2 * 20 + b) * 64 + j2];
            mod[b * 6144 + blockIdx.x * 64 + j2] = s; }
        __syncthreads();
    }
    for (int t = blockIdx.x; t < 960; t += gridDim.x) weight_tile(p, lds, t);
}

__device__ void phase_h1(const P& p, unsigned char* lds) {
    const int tid = threadIdx.x, lane = tid & 63, wv = __builtin_amdgcn_readfirstlane(tid >> 6), fr = lane & 15, g4 = lane >> 4;
    const float* mod = (const float*)(p.ws + OFF_MOD); u16* h1 = (u16*)(p.ws); float* small = (float*)(p.ws + OFF_SMALL);
    const u16* Wb1 = (const u16*)(p.ws + OFF_WB1); u16* LW = (u16*)lds;
    for (int pc = tid; pc < 4096; pc += 512) { const int n = pc >> 7, c8 = pc & 127; *(u32x4*)(LW + n * 1032 + c8 * 8) = *(const u32x4*)(Wb1 + (size_t)(3584 + n) * 1024 + c8 * 8); }
    __syncthreads();
    for (int tile = blockIdx.x * 8 + wv; tile < NTOK / 16; tile += gridDim.x * 8) {
        const int R = tile * 16 + fr; const int s = seq_of_row(tile * 16);
        const float* xr = (R < 32768 ? p.x_prompt + (size_t)R * 1024 : p.x_sample + (size_t)(R - 32768) * 1024) + g4 * 8;
        const float* m = mod + s * 6144 + g4 * 8; u16* hr = h1 + (size_t)R * 1024 + g4 * 8;
        f32x4 acc0 = (f32x4){0.f, 0.f, 0.f, 0.f}, acc1 = (f32x4){0.f, 0.f, 0.f, 0.f};
#pragma unroll 4
        for (int ks = 0; ks < 32; ++ks) {
            const f32x4 a = *(const f32x4*)(xr + ks * 32), b = *(const f32x4*)(xr + ks * 32 + 4);
            const f32x4 sh0 = *(const f32x4*)(m + ks * 32), sh1 = *(const f32x4*)(m + ks * 32 + 4), sc0 = *(const f32x4*)(m + 1024 + ks * 32), sc1 = *(const f32x4*)(m + 1028 + ks * 32);
            const f32x4 o0 = a * (1.f + sc0) + sh0, o1 = b * (1.f + sc1) + sh1;
            u32x4 w; w.x = pk(o0[0], o0[1]); w.y = pk(o0[2], o0[3]); w.z = pk(o1[0], o1[1]); w.w = pk(o1[2], o1[3]);
            *(u32x4*)(hr + ks * 32) = w;
            const bf16x8 af = asbf(w);
            const bf16x8 b0 = *(const bf16x8*)(LW + fr * 1032 + ks * 32 + g4 * 8), b1 = *(const bf16x8*)(LW + (16 + fr) * 1032 + ks * 32 + g4 * 8);
            acc0 = mfma16(af, b0, acc0); acc1 = mfma16(af, b1, acc1);
        }
#pragma unroll
        for (int r = 0; r < 4; ++r) { float* sp = small + (size_t)(tile * 16 + 4 * g4 + r) * 32 + fr; sp[0] = acc0[r]; sp[16] = acc1[r]; }
    }
}

__device__ void phase_conv(const P& p, unsigned char* lds) {
    const u16* Pqkv = (const u16*)(p.ws + 2 * U); const u16* Pxbc = (const u16*)(p.ws + 5 * U);
    u16* Cq = (u16*)(p.ws + 9 * U); u16* Ck = (u16*)((unsigned char*)p.out); u16* vT = (u16*)((unsigned char*)p.out + U); u16* kT = (u16*)((unsigned char*)p.out + 2 * U);
    u16* xT = (u16*)(p.ws); u16* BmT = (u16*)(p.ws + U); u16* Bm = (u16*)(p.ws + U + U / 2); u16* Cm = (u16*)((unsigned char*)p.out + 3 * U);
    u16* LT = (u16*)lds;
    const int tid0 = threadIdx.x;
    for (int bi = blockIdx.x; bi < 768 * 5; bi += gridDim.x) {
        int tid = tid0; asm volatile("" : "+v"(tid));
        const int cgl = tid & 63, tb = tid >> 6;
        const int tile = bi / 5, cb = bi - tile * 5;
        const int Rt = tile * 128; const int s = seq_of_row(Rt); int T, row0; seq_info(s, T, row0); const int tt0 = Rt - row0;
        const bool dn = cb < 3; const int c = (dn ? cb * 512 : (cb - 3) * 512) + cgl * 8; const int cl = cgl * 8;
        const u16* src = dn ? Pqkv : Pxbc; const int ld = dn ? 1536 : 1024; const float* cw = dn ? p.dn_conv_w : p.ssm_conv_w;
        float w[5][8];
#pragma unroll
        for (int i = 0; i < 5; ++i) { const f32x4 a = *(const f32x4*)(cw + i * ld + c), b = *(const f32x4*)(cw + i * ld + c + 4);
#pragma unroll
            for (int j = 0; j < 4; ++j) { w[i][j] = a[j]; w[i][4 + j] = b[j]; } }
        float bias[8];
#pragma unroll
        for (int j = 0; j < 8; ++j) bias[j] = dn ? 0.f : p.ssm_conv_b[c + j];
        const bool has_tr = (cb == 1) || (cb == 2) || (cb == 3) || (cb == 4 && cl < 256);
#pragma unroll 1
        for (int half = 0; half < 2; ++half) {
            const int tblk = tb + half * 8;
            const int t0 = tt0 + tblk * 8; const int R0 = row0 + t0;
            float acc[8][8];
#pragma unroll
            for (int tt = 0; tt < 8; ++tt)
#pragma unroll
                for (int j = 0; j < 8; ++j) acc[tt][j] = bias[j];
#pragma unroll
            for (int r = 0; r < 12; ++r) { const int t = t0 + r - 2;
                u32x4 v = (u32x4){0u, 0u, 0u, 0u};
                if (t >= 0 && t < T) v = *(const u32x4*)(src + (size_t)(row0 + t) * ld + c);
                float f[8]; f[0] = blo(v.x); f[1] = bhi(v.x); f[2] = blo(v.y); f[3] = bhi(v.y); f[4] = blo(v.z); f[5] = bhi(v.z); f[6] = blo(v.w); f[7] = bhi(v.w);
#pragma unroll
                for (int i = 0; i < 5; ++i) { const int tt = r - i; if (tt >= 0 && tt < 8) {
#pragma unroll
                    for (int j = 0; j < 8; ++j) acc[tt][j] += w[i][j] * f[j]; } } }
#pragma unroll
            for (int tt = 0; tt < 8; ++tt)
#pragma unroll
                for (int j = 0; j < 8; ++j) acc[tt][j] = silu_f(acc[tt][j]);
            if (cb < 2) {
#pragma unroll
                for (int tt = 0; tt < 8; ++tt) { float ss = 0.f;
#pragma unroll
                    for (int j = 0; j < 8; ++j) ss += acc[tt][j] * acc[tt][j];
                    ss += __shfl_xor(ss, 1); ss += __shfl_xor(ss, 2); ss += __shfl_xor(ss, 4); ss += __shfl_xor(ss, 8);
                    float sc = rsqrtf(ss + 1e-6f); if (cb == 0) sc *= 0.08838834764831845f;
#pragma unroll
                    for (int j = 0; j < 8; ++j) acc[tt][j] *= sc; }
            }
            u16* rm = nullptr; int rld = 0, rc = 0;
            if (cb == 0) { rm = Cq; rld = 512; rc = cl; } else if (cb == 1) { rm = Ck; rld = 512; rc = cl; }
            else if (cb == 4) { if (cl >= 256) { rm = Cm; rld = 256; rc = cl - 256; } else { rm = Bm; rld = 256; rc = cl; } }
            if (rm) {
#pragma unroll
                for (int tt = 0; tt < 8; ++tt) { u32x4 o; o.x = pk(acc[tt][0], acc[tt][1]); o.y = pk(acc[tt][2], acc[tt][3]); o.z = pk(acc[tt][4], acc[tt][5]); o.w = pk(acc[tt][6], acc[tt][7]);
                    *(u32x4*)(rm + (size_t)(R0 + tt) * rld + rc) = o; }
            }
            if (has_tr) {
#pragma unroll
                for (int j = 0; j < 8; ++j) { u32x4 o; o.x = pk(acc[0][j], acc[1][j]); o.y = pk(acc[2][j], acc[3][j]); o.z = pk(acc[4][j], acc[5][j]); o.w = pk(acc[6][j], acc[7][j]);
                    *(u32x4*)(LT + (cl + j) * 136 + tblk * 8) = o; }
            }
        }
        if (cb != 0) {
            __syncthreads();
            u16* tr; int tw, nrows;
            if (cb == 1) { tr = kT; tw = 512; nrows = 512; } else if (cb == 2) { tr = vT; tw = 512; nrows = 512; } else if (cb == 3) { tr = xT; tw = 512; nrows = 512; } else { tr = BmT; tw = 256; nrows = 256; }
            for (int q = tid; q < nrows * 16; q += 512) { const int row = q >> 4, ch = q & 15;
                u16* dstp = (cb <= 2) ? tr + ((size_t)((Rt >> 6) + (ch >> 3)) * 512 + row) * 64 + (ch & 7) * 8
                                      : tr + ((size_t)(Rt >> 7) * tw + row) * 128 + ch * 8;
                *(u32x4*)dstp = *(const u32x4*)(LT + row * 136 + ch * 8); }
            __syncthreads();
        }
    }
}

__device__ void phase_dnprep(const P& p, unsigned char* lds) {
    const int tid = threadIdx.x, lane0 = tid & 63, wv = __builtin_amdgcn_readfirstlane(tid >> 6);
    const u16* Cq = (const u16*)(p.ws + 9 * U); const u16* Ck = (const u16*)((unsigned char*)p.out); const u16* vT = (const u16*)((unsigned char*)p.out + U); const u16* kT = (const u16*)((unsigned char*)p.out + 2 * U);
    u16* wbuf = (u16*)(p.ws + 2 * U); u16* attn = (u16*)(p.ws + 4 * U); u16* ubuf = (u16*)(p.ws + 5 * U);
    const float* small = (const float*)(p.ws + OFF_SMALL); float* gcum = (float*)(p.ws + OFF_GCUM);
    float* Lw = (float*)(lds + wv * 17408);
    for (int unit = blockIdx.x * 8 + wv; unit < 12288; unit += gridDim.x * 8) {
        int lane = lane0; asm volatile("" : "+v"(lane));
        const int fr = lane & 15, g4 = lane >> 4;
        const int dir = unit & 1, h = (unit >> 1) & 3, chunk = unit >> 3; const int Rc = chunk * 64;
        const int s = seq_of_row(Rc); int T, row0; seq_info(s, T, row0);
        const int Ri = Rc + (dir ? 63 - lane : lane);
        const float a_raw = small[(size_t)Ri * 32 + dir * 4 + h], b_raw = small[(size_t)Ri * 32 + 8 + dir * 4 + h];
        bf16x8 kf[4][4], qf[4][4];
        const int vr0 = dir ? 63 - fr : fr, vstep = dir ? -16 : 16;
        const u16* kp = Ck + (size_t)(Rc + vr0) * 512 + h * 128 + g4 * 8; const u16* qp = Cq + (size_t)(Rc + vr0) * 512 + h * 128 + g4 * 8;
#pragma unroll
        for (int it = 0; it < 4; ++it) {
#pragma unroll
            for (int ks = 0; ks < 4; ++ks) { kf[it][ks] = *(const bf16x8*)(kp + it * vstep * 512 + ks * 32); qf[it][ks] = *(const bf16x8*)(qp + it * vstep * 512 + ks * 32); } }
        const float gl = -__expf(p.dn_A_log[dir * 4 + h]) * softplus_f(a_raw + p.dn_dt_bias[dir * 4 + h]);
        const float beta = __builtin_amdgcn_rcpf(1.f + __expf(-b_raw));
        float g = gl;
#pragma unroll
        for (int o = 1; o < 64; o <<= 1) { const float t = __shfl_up(g, o); if (lane >= o) g += t; }
        { const float glast = __shfl(g, 63); gcum[(size_t)unit * 128 + lane] = __expf(g); gcum[(size_t)unit * 128 + 64 + lane] = __expf(glast - g); }
        float gj[4];
#pragma unroll
        for (int jt = 0; jt < 4; ++jt) gj[jt] = __shfl(g, jt * 16 + fr);
#pragma unroll
        for (int it = 0; it < 4; ++it) {
            float gi[4], bi[4];
#pragma unroll
            for (int r = 0; r < 4; ++r) { gi[r] = __shfl(g, it * 16 + 4 * g4 + r); bi[r] = __shfl(beta, it * 16 + 4 * g4 + r); }
#pragma unroll
            for (int jt = 0; jt < 4; ++jt) {
                float av[4] = {0.f, 0.f, 0.f, 0.f};
                if (jt <= it) {
                    f32x4 kk = (f32x4){0.f, 0.f, 0.f, 0.f}, qk = (f32x4){0.f, 0.f, 0.f, 0.f};
#pragma unroll
                    for (int ks = 0; ks < 4; ++ks) { kk = mfma16(kf[it][ks], kf[jt][ks], kk); qk = mfma16(qf[it][ks], kf[jt][ks], qk); }
#pragma unroll
                    for (int r = 0; r < 4; ++r) { const int i = it * 16 + 4 * g4 + r, j = jt * 16 + fr; const float dec = __expf(fminf(gi[r] - gj[jt], 0.f));
                        Lw[i * 68 + j] = (j < i) ? bi[r] * kk[r] * dec : 0.f; av[r] = (j <= i) ? qk[r] * dec : 0.f; }
                }
#pragma unroll
                for (int r = 0; r < 4; ++r) attn[(size_t)unit * 4096 + (it * 16 + 4 * g4 + r) * 64 + jt * 16 + fr] = f2bf(av[r]);
                __builtin_amdgcn_sched_barrier(0);
            }
        }
        u32x4 AF[2][8][2];
#pragma unroll
        for (int mat = 0; mat < 2; ++mat) { const u16* srcT = (mat ? vT : kT) + ((size_t)chunk * 512 + h * 128) * 64;
#pragma unroll
            for (int dt = 0; dt < 8; ++dt)
#pragma unroll
                for (int ks = 0; ks < 2; ++ks) { const int joff = dir ? (56 - ks * 32 - g4 * 8) : (ks * 32 + g4 * 8); AF[mat][dt][ks] = *(const u32x4*)(srcT + (dt * 16 + fr) * 64 + joff); } }
        asm volatile("s_waitcnt lgkmcnt(0)" ::: "memory");
        { const int bb = lane >> 4, cc = lane & 15; float* Ld = Lw + (16 * bb) * 68 + 16 * bb;
          float d[16];
#pragma unroll
          for (int i = 0; i < 16; ++i) { float acc = (cc == i) ? 1.f : 0.f;
#pragma unroll
              for (int j4 = 0; j4 < i; j4 += 4) { const f32x4 l4 = *(const f32x4*)(Ld + i * 68 + j4);
                  acc -= l4[0] * d[j4]; if (j4 + 1 < i) acc -= l4[1] * d[j4 + 1]; if (j4 + 2 < i) acc -= l4[2] * d[j4 + 2]; if (j4 + 3 < i) acc -= l4[3] * d[j4 + 3]; }
              d[i] = acc; }
          asm volatile("s_waitcnt lgkmcnt(0)" ::: "memory");
#pragma unroll
          for (int i = 0; i < 16; ++i) Ld[i * 68 + cc] = d[i]; }
        asm volatile("s_waitcnt lgkmcnt(0)" ::: "memory");
#pragma unroll
        for (int J = 0; J < 3; ++J)
#pragma unroll
            for (int I = J + 1; I < 4; ++I) {
                f32x4 X = (f32x4){0.f, 0.f, 0.f, 0.f};
#pragma unroll
                for (int K = J; K < I; ++K)
#pragma unroll
                    for (int q = 0; q < 4; ++q) { const float av = Lw[(16 * I + fr) * 68 + 16 * K + 4 * q + g4], bv = Lw[(16 * K + 4 * q + g4) * 68 + 16 * J + fr];
                        X = __builtin_amdgcn_mfma_f32_16x16x4f32(av, bv, X, 0, 0, 0); }
                f32x4 Y = (f32x4){0.f, 0.f, 0.f, 0.f};
#pragma unroll
                for (int q = 0; q < 4; ++q) { const float av = Lw[(16 * I + fr) * 68 + 16 * I + 4 * g4 + q]; Y = __builtin_amdgcn_mfma_f32_16x16x4f32(av, X[q], Y, 0, 0, 0); }
                asm volatile("s_waitcnt lgkmcnt(0)" ::: "memory");
#pragma unroll
                for (int r = 0; r < 4; ++r) Lw[(16 * I + 4 * g4 + r) * 68 + 16 * J + fr] = -Y[r];
                asm volatile("s_waitcnt lgkmcnt(0)" ::: "memory");
            }
        float* Sc = (float*)(lds + 139264 + wv * 512);
        Sc[lane] = beta * __expf(g); Sc[64 + lane] = beta;
        asm volatile("s_waitcnt lgkmcnt(0)" ::: "memory");
#pragma unroll
        for (int mat = 0; mat < 2; ++mat) {
            u16* dst = (mat ? ubuf : wbuf) + (size_t)unit * 8192;
            bf16x8 bfr[4][2];
#pragma unroll
            for (int itl = 0; itl < 4; ++itl)
#pragma unroll
                for (int ks = 0; ks < 2; ++ks) { u32x4 fv = (u32x4){0u, 0u, 0u, 0u};
                    if (2 * ks + (g4 >> 1) <= itl) { const float* tp = Lw + (itl * 16 + fr) * 68 + ks * 32 + g4 * 8; const float* sp = Sc + mat * 64 + ks * 32 + g4 * 8;
                        const f32x4 t0 = *(const f32x4*)tp, t1 = *(const f32x4*)(tp + 4), s0 = *(const f32x4*)sp, s1 = *(const f32x4*)(sp + 4);
                        fv.x = pk(t0[0] * s0[0], t0[1] * s0[1]); fv.y = pk(t0[2] * s0[2], t0[3] * s0[3]); fv.z = pk(t1[0] * s1[0], t1[1] * s1[1]); fv.w = pk(t1[2] * s1[2], t1[3] * s1[3]); }
                    bfr[itl][ks] = asbf(fv); }
#pragma unroll
            for (int dt = 0; dt < 8; ++dt) {
                bf16x8 af[2];
#pragma unroll
                for (int ks = 0; ks < 2; ++ks) { u32x4 raw = AF[mat][dt][ks]; if (dir) raw = rev8(raw); af[ks] = asbf(raw); }
#pragma unroll
                for (int itl = 0; itl < 4; ++itl) { f32x4 c = (f32x4){0.f, 0.f, 0.f, 0.f};
#pragma unroll
                    for (int ks = 0; ks < 2; ++ks) c = mfma16(af[ks], bfr[itl][ks], c);
                    u32x2 w2; w2.x = pk(c[0], c[1]); w2.y = pk(c[2], c[3]);
                    *(u32x2*)(dst + (itl * 16 + fr) * 128 + dt * 16 + 4 * g4) = w2; }
            }
        }
        asm volatile("s_waitcnt lgkmcnt(0)" ::: "memory");
    }
    const u16* Bm = (const u16*)(p.ws + U + U / 2); const u16* Cm = (const u16*)((unsigned char*)p.out + 3 * U); u16* CBp = (u16*)((unsigned char*)p.out + 3 * U + U / 2);
    for (int unit = blockIdx.x; unit < 1536; unit += gridDim.x) {
        const int fr = lane0 & 15, g4 = lane0 >> 4;
        const int g = unit & 1, ck = unit >> 1; const int Rc = ck * 128;
        bf16x8 cf[4];
#pragma unroll
        for (int ks = 0; ks < 4; ++ks) cf[ks] = *(const bf16x8*)(Cm + (size_t)(Rc + wv * 16 + fr) * 256 + g * 128 + ks * 32 + g4 * 8);
#pragma unroll 2
        for (int st = 0; st < 8; ++st) { f32x4 c = (f32x4){0.f, 0.f, 0.f, 0.f};
#pragma unroll
            for (int ks = 0; ks < 4; ++ks) { const bf16x8 bfg = *(const bf16x8*)(Bm + (size_t)(Rc + st * 16 + fr) * 256 + g * 128 + ks * 32 + g4 * 8); c = mfma16(bfg, cf[ks], c); }
            u32x2 w2; w2.x = pk(c[0], c[1]); w2.y = pk(c[2], c[3]);
            *(u32x2*)(CBp + (size_t)unit * 16384 + (wv * 16 + fr) * 128 + st * 16 + 4 * g4) = w2; }
    }
}

__device__ void dn_scan_item(const P& p, unsigned char* lds, int s, int h, int dir) {
    int T, row0; seq_info(s, T, row0); const int NC = T / 64;
    const int tid0 = threadIdx.x;
    const u16* Cq = (const u16*)(p.ws + 9 * U); const u16* kT = (const u16*)((unsigned char*)p.out + 2 * U);
    const u16* wbuf = (const u16*)(p.ws + 2 * U); const u16* attn = (const u16*)(p.ws + 4 * U); u16* ubuf = (u16*)(p.ws + 5 * U);
    const float* gcum = (const float*)(p.ws + OFF_GCUM);
    u16* Lw_ = (u16*)lds; u16* Lq = Lw_ + 64 * 136; u16* Lu = Lq + 64 * 136; u16* Lk = Lu + 64 * 136; u16* La = Lk + 128 * 72; float* Lg = (float*)(La + 64 * 72);
    f32x4 S[8];
#pragma unroll
    for (int i = 0; i < 8; ++i) S[i] = (f32x4){0.f, 0.f, 0.f, 0.f};
    u32x4 pw[2], pu[2], pq[2], pk2[2], pa; float pg = 0.f; size_t prev_unit = 0;
    unsigned vo_wu[2], vo_q[2], vo_k[2]; const unsigned vo_a = (unsigned)tid0 * 16u, vo_g = (unsigned)tid0 * 4u;
#pragma unroll
    for (int k = 0; k < 2; ++k) { const int pc = tid0 + k * 512; const int i = pc >> 4, c8 = pc & 15; const int d = pc >> 3, j8 = pc & 7;
        vo_wu[k] = (unsigned)pc * 16u; vo_q[k] = (unsigned)((dir ? 63 - i : i) * 512 + c8 * 8) * 2u; vo_k[k] = (unsigned)(d * 64 + (dir ? 56 - j8 * 8 : j8 * 8)) * 2u; }
#define DN_ISSUE(NV, TID) do { const int nreal_ = dir ? NC - 1 - (NV) : (NV); const size_t unit_ = (size_t)((((row0 >> 6) + nreal_) * 4 + h) * 2 + dir); const int Rc_ = row0 + nreal_ * 64; \
        const char* bw_ = (const char*)(wbuf + unit_ * 8192); const char* bu_ = (const char*)(ubuf + unit_ * 8192); const char* bq_ = (const char*)(Cq + (size_t)Rc_ * 512 + h * 128); \
        const char* bk_ = (const char*)(kT + ((size_t)((row0 >> 6) + nreal_) * 512 + h * 128) * 64); const char* ba_ = (const char*)(attn + unit_ * 4096); const char* bg_ = (const char*)(gcum + unit_ * 128); \
        _Pragma("unroll") for (int k = 0; k < 2; ++k) { pw[k] = *(const u32x4*)(bw_ + vo_wu[k]); pu[k] = *(const u32x4*)(bu_ + vo_wu[k]); pq[k] = *(const u32x4*)(bq_ + vo_q[k]); pk2[k] = *(const u32x4*)(bk_ + vo_k[k]); } \
        pa = *(const u32x4*)(ba_ + vo_a); if ((TID) < 128) pg = *(const float*)(bg_ + vo_g); } while (0)
    DN_ISSUE(0, tid0);
    for (int nv = 0; nv < NC; ++nv) {
        int tid = tid0; asm volatile("" : "+v"(tid));
        const int lane = tid & 63, wv = tid >> 6, fr = lane & 15, g4 = lane >> 4; const int e = wv * 16 + fr;
        const int nreal = dir ? NC - 1 - nv : nv; const int chunk = row0 / 64 + nreal; const size_t unit = (size_t)((chunk * 4 + h) * 2 + dir);
        __syncthreads();
        if (nv > 0) {
#pragma unroll
            for (int k = 0; k < 2; ++k) { const int pc = tid + k * 512; const int i = pc >> 4, c8 = pc & 15; *(u32x4*)(ubuf + prev_unit * 8192 + pc * 8) = *(const u32x4*)(Lu + i * 136 + c8 * 8); } }
        prev_unit = unit;
#pragma unroll
        for (int k = 0; k < 2; ++k) { const int pc = tid + k * 512; const int i = pc >> 4, c8 = pc & 15;
            *(u32x4*)(Lw_ + i * 136 + c8 * 8) = pw[k]; *(u32x4*)(Lu + i * 136 + c8 * 8) = pu[k]; *(u32x4*)(Lq + i * 136 + c8 * 8) = pq[k];
            const int d = pc >> 3, j8 = pc & 7; *(u32x4*)(Lk + d * 72 + j8 * 8) = dir ? rev8(pk2[k]) : pk2[k]; }
        { const int i = tid >> 3, j8 = tid & 7; *(u32x4*)(La + i * 72 + j8 * 8) = pa; }
        if (tid < 128) Lg[tid] = pg;
        __syncthreads();
        if (nv + 1 < NC) DN_ISSUE(nv + 1, tid);
        bf16x8 Sb[4];
#pragma unroll
        for (int Q = 0; Q < 4; ++Q) Sb[Q] = packB(S[2 * Q], S[2 * Q + 1]);
        f32x4 vn[4], oa[4];
#pragma unroll
        for (int it = 0; it < 4; ++it) {
            f32x4 a1 = (f32x4){0.f, 0.f, 0.f, 0.f}, a2 = (f32x4){0.f, 0.f, 0.f, 0.f};
#pragma unroll
            for (int Q = 0; Q < 4; ++Q) { const bf16x8 Aw = ldA2(Lw_ + (it * 16 + fr) * 136 + 32 * Q + 4 * g4), Aq = ldA2(Lq + (it * 16 + fr) * 136 + 32 * Q + 4 * g4);
                a1 = mfma16(Aw, Sb[Q], a1); a2 = mfma16(Aq, Sb[Q], a2); }
#pragma unroll
            for (int r = 0; r < 4; ++r) { const int i = it * 16 + 4 * g4 + r; vn[it][r] = bf2f(Lu[i * 136 + e]) - a1[r]; oa[it][r] = a2[r] * Lg[i]; }
        }
        const float egl = Lg[63];
        bf16x8 Vb[2], Vs[2];
#pragma unroll
        for (int Qj = 0; Qj < 2; ++Qj) { Vb[Qj] = packB(vn[2 * Qj], vn[2 * Qj + 1]); f32x4 s0, s1;
#pragma unroll
            for (int r = 0; r < 4; ++r) { s0[r] = vn[2 * Qj][r] * Lg[64 + (2 * Qj) * 16 + 4 * g4 + r]; s1[r] = vn[2 * Qj + 1][r] * Lg[64 + (2 * Qj + 1) * 16 + 4 * g4 + r]; }
            Vs[Qj] = packB(s0, s1); }
#pragma unroll
        for (int it = 0; it < 4; ++it) {
#pragma unroll
            for (int Qj = 0; Qj < 2; ++Qj) { const bf16x8 Aa = ldA2(La + (it * 16 + fr) * 72 + 32 * Qj + 4 * g4); oa[it] = mfma16(Aa, Vb[Qj], oa[it]); }
#pragma unroll
            for (int r = 0; r < 4; ++r) Lu[(it * 16 + 4 * g4 + r) * 136 + e] = f2bf(oa[it][r]);
        }
#pragma unroll
        for (int dt = 0; dt < 8; ++dt) { S[dt] *= egl;
#pragma unroll
            for (int Qj = 0; Qj < 2; ++Qj) { const bf16x8 Ak = ldA2(Lk + (dt * 16 + fr) * 72 + 32 * Qj + 4 * g4); S[dt] = mfma16(Ak, Vs[Qj], S[dt]); }
            }
    }
    __syncthreads();
    { const int tid = tid0;
#pragma unroll
      for (int k = 0; k < 2; ++k) { const int pc = tid + k * 512; const int i = pc >> 4, c8 = pc & 15; *(u32x4*)(ubuf + prev_unit * 8192 + pc * 8) = *(const u32x4*)(Lu + i * 136 + c8 * 8); } }
#undef DN_ISSUE
}

__device__ void ssd_item(const P& p, unsigned char* lds, int s, int hh, int dir) {
    int T, row0; seq_info(s, T, row0); const int NC = T / 128; const int gg = hh >> 2;
    const int tid0 = threadIdx.x;
    const u16* xT = (const u16*)(p.ws); const u16* BmT = (const u16*)(p.ws + U); const u16* Cm = (const u16*)((unsigned char*)p.out + 3 * U); const u16* CBp = (const u16*)((unsigned char*)p.out + 3 * U + U / 2);
    const float* small = (const float*)(p.ws + OFF_SMALL);
    u16* ybuf = (u16*)((unsigned char*)p.out + (size_t)dir * U);
    u16* LM = (u16*)lds; u16* LC = LM + 128 * 136; u16* LB = LC + 128 * 136; u16* LX = LB + 128 * 136; float* Wbase = (float*)(LX + 64 * 136);
    const float A = -__expf(p.ssm_A_log[dir * 8 + hh]); const float dtb = p.ssm_dt_bias[dir * 8 + hh]; const float Dh = p.ssm_D[hh];
    f32x4 S[8];
#pragma unroll
    for (int i = 0; i < 8; ++i) S[i] = (f32x4){0.f, 0.f, 0.f, 0.f};
    u32x4 pcm[4], pbm[4], pxx[2], pcb[4]; float pd0 = 0.f, pd1 = 0.f;
#define SSD_ISSUE(CV, TID) do { const int creal_ = dir ? NC - 1 - (CV) : (CV); const int Rc_ = row0 + creal_ * 128; const int ln_ = (TID) & 63; \
        pd0 = small[(size_t)(Rc_ + (dir ? 127 - ln_ : ln_)) * 32 + 16 + dir * 8 + hh]; pd1 = small[(size_t)(Rc_ + (dir ? 63 - ln_ : 64 + ln_)) * 32 + 16 + dir * 8 + hh]; \
        _Pragma("unroll") for (int k = 0; k < 4; ++k) { const int pc = (TID) + k * 512; const int l = pc >> 4, c8 = pc & 15; const size_t Rr = (size_t)(Rc_ + (dir ? 127 - l : l)); \
            pcm[k] = *(const u32x4*)(Cm + Rr * 256 + gg * 128 + c8 * 8); const int loff = dir ? 120 - c8 * 8 : c8 * 8; \
            pbm[k] = *(const u32x4*)(BmT + ((size_t)((row0 >> 7) + creal_) * 256 + gg * 128 + l) * 128 + loff); } \
        _Pragma("unroll") for (int k = 0; k < 2; ++k) { const int pc = (TID) + k * 512; const int pp = pc >> 4, l8 = pc & 15; const int loff = dir ? 120 - l8 * 8 : l8 * 8; \
            pxx[k] = *(const u32x4*)(xT + ((size_t)((row0 >> 7) + creal_) * 512 + hh * 64 + pp) * 128 + loff); } \
        { const int l = (TID) >> 2, sq = ((TID) & 3) * 32; const int lr = dir ? 127 - l : l; const u16* cbrow = CBp + (size_t)((Rc_ >> 7) * 2 + gg) * 16384 + lr * 128; \
          _Pragma("unroll") for (int k8 = 0; k8 < 4; ++k8) { const int s0 = sq + k8 * 8; pcb[k8] = (u32x4){0u, 0u, 0u, 0u}; if (s0 <= l) pcb[k8] = *(const u32x4*)(cbrow + (dir ? 120 - s0 : s0)); } } } while (0)
    SSD_ISSUE(0, tid0);
    for (int cv = 0; cv < NC; ++cv) {
        int tid = tid0; asm volatile("" : "+v"(tid));
        const int lane = tid & 63, wv = __builtin_amdgcn_readfirstlane(tid >> 6), fr = lane & 15, g4 = lane >> 4;
        const int lh = wv & 1, pb = wv >> 1; const int pcol = pb * 16 + fr;
        float* Wdt = Wbase + wv * 512; float* Wacs = Wdt + 128; float* Wf = Wacs + 128; float* We = Wf + 128;
        const int creal = dir ? NC - 1 - cv : cv; const int Rc = row0 + creal * 128;
        __syncthreads();
        { const float dt0 = softplus_f(pd0 + dtb), dt1 = softplus_f(pd1 + dtb); float a0 = dt0 * A, a1 = dt1 * A;
#pragma unroll
          for (int o = 1; o < 64; o <<= 1) { const float t0 = __shfl_up(a0, o), t1 = __shfl_up(a1, o); if (lane >= o) { a0 += t0; a1 += t1; } }
          a1 += __shfl(a0, 63); const float a127 = __shfl(a1, 63);
          Wdt[lane] = dt0; Wdt[64 + lane] = dt1; Wacs[lane] = a0; Wacs[64 + lane] = a1; Wf[lane] = __expf(a127 - a0) * dt0; Wf[64 + lane] = __expf(a127 - a1) * dt1;
          We[lane] = __expf(__shfl(a0, lane | 7) - a0) * dt0; We[64 + lane] = __expf(__shfl(a1, lane | 7) - a1) * dt1; }
        asm volatile("s_waitcnt lgkmcnt(0)" ::: "memory");
#pragma unroll
        for (int k = 0; k < 4; ++k) { const int pc = tid + k * 512; const int l = pc >> 4, c8 = pc & 15;
            *(u32x4*)(LC + l * 136 + c8 * 8) = pcm[k]; *(u32x4*)(LB + l * 136 + c8 * 8) = dir ? rev8(pbm[k]) : pbm[k]; }
#pragma unroll
        for (int k = 0; k < 2; ++k) { const int pc = tid + k * 512; const int pp = pc >> 4, l8 = pc & 15; *(u32x4*)(LX + pp * 136 + l8 * 8) = dir ? rev8(pxx[k]) : pxx[k]; }
        { const int l = tid >> 2, sq = (tid & 3) * 32; const float al = Wacs[l];
#pragma unroll
          for (int k8 = 0; k8 < 4; ++k8) { const int s0 = sq + k8 * 8; u32x4 o4 = (u32x4){0u, 0u, 0u, 0u};
              if (s0 <= l) { const u32x4 raw = dir ? rev8(pcb[k8]) : pcb[k8];
                  float v[8]; v[0] = blo(raw.x); v[1] = bhi(raw.x); v[2] = blo(raw.y); v[3] = bhi(raw.y); v[4] = blo(raw.z); v[5] = bhi(raw.z); v[6] = blo(raw.w); v[7] = bhi(raw.w);
                  if (s0 + 7 <= l) { const float fgrp = __expf(fminf(al - Wacs[s0 + 7], 0.f)); const f32x4 e0 = *(const f32x4*)(We + s0), e1 = *(const f32x4*)(We + s0 + 4);
#pragma unroll
                      for (int e8 = 0; e8 < 4; ++e8) { v[e8] *= fgrp * e0[e8]; v[4 + e8] *= fgrp * e1[e8]; } }
                  else {
#pragma unroll
                      for (int e8 = 0; e8 < 8; ++e8) { const int sx = s0 + e8; v[e8] = (sx <= l) ? v[e8] * __expf(fminf(al - Wacs[sx], 0.f)) * Wdt[sx] : 0.f; } }
                  o4.x = pk(v[0], v[1]); o4.y = pk(v[2], v[3]); o4.z = pk(v[4], v[5]); o4.w = pk(v[6], v[7]); }
              *(u32x4*)(LM + l * 136 + s0) = o4; } }
        __syncthreads();
        if (cv + 1 < NC) SSD_ISSUE(cv + 1, tid);
        bf16x8 Sb[4];
#pragma unroll
        for (int Q = 0; Q < 4; ++Q) Sb[Q] = packB(S[2 * Q], S[2 * Q + 1]);
        const float e127 = __expf(Wacs[127]);
        bf16x8 xf[4], xsf[4];
#pragma unroll
        for (int ks = 0; ks < 4; ++ks) { const u32x4 raw = *(const u32x4*)(LX + pcol * 136 + ks * 32 + g4 * 8); xf[ks] = asbf(raw); const float* fp = Wf + ks * 32 + g4 * 8;
            u32x4 sc; sc.x = pk(blo(raw.x) * fp[0], bhi(raw.x) * fp[1]); sc.y = pk(blo(raw.y) * fp[2], bhi(raw.y) * fp[3]); sc.z = pk(blo(raw.z) * fp[4], bhi(raw.z) * fp[5]); sc.w = pk(blo(raw.w) * fp[6], bhi(raw.w) * fp[7]);
            xsf[ks] = asbf(sc); }
#pragma unroll
        for (int lt = 0; lt < 4; ++lt) {
            const int lbase = lh * 64 + lt * 16;
            f32x4 yo = (f32x4){0.f, 0.f, 0.f, 0.f};
#pragma unroll
            for (int Q = 0; Q < 4; ++Q) { const bf16x8 Ac = ldA2(LC + (lbase + fr) * 136 + 32 * Q + 4 * g4); yo = mfma16(Ac, Sb[Q], yo); }
#pragma unroll
            for (int r = 0; r < 4; ++r) yo[r] *= __expf(Wacs[lbase + 4 * g4 + r]);
            const int ksmax = (lbase + 15) >> 5;
#pragma unroll
            for (int ks = 0; ks < 4; ++ks) if (ks <= ksmax) { const bf16x8 Am = *(const bf16x8*)(LM + (lbase + fr) * 136 + ks * 32 + g4 * 8); yo = mfma16(Am, xf[ks], yo); }
            if (dir == 0) { const u32x2 xx = *(const u32x2*)(LX + pcol * 136 + lbase + 4 * g4); yo[0] += Dh * blo(xx.x); yo[1] += Dh * bhi(xx.x); yo[2] += Dh * blo(xx.y); yo[3] += Dh * bhi(xx.y); }
#pragma unroll
            for (int r = 0; r < 4; ++r) { const int l = lbase + 4 * g4 + r; const size_t Rr = (size_t)(Rc + (dir ? 127 - l : l)); ybuf[Rr * 512 + hh * 64 + pcol] = f2bf(yo[r]); }
        }
#pragma unroll
        for (int nt = 0; nt < 8; ++nt) { S[nt] *= e127;
#pragma unroll
            for (int ks = 0; ks < 4; ++ks) { const bf16x8 Ab = *(const bf16x8*)(LB + (nt * 16 + fr) * 136 + ks * 32 + g4 * 8); S[nt] = mfma16(Ab, xsf[ks], S[nt]); }
            }
    }
#undef SSD_ISSUE
}

__device__ void phase_scan(const P& p, unsigned char* lds) {
    unsigned* cnt = (unsigned*)(p.ws + OFF_CNT);
    int* slot = (int*)(lds + LDS_BYTES - 16);
    for (;;) {
        __syncthreads();
        if (threadIdx.x == 0) *slot = (int)atomicAdd(cnt, 1u);
        __syncthreads();
        const int q = __builtin_amdgcn_readfirstlane(*slot);
        if (q >= 480) break;
        int isdn, r, sb;
        if (q < 32) { isdn = 1; r = q; sb = 0; } else if (q < 96) { isdn = 0; r = q - 32; sb = 0; } else if (q < 224) { isdn = 1; r = q - 96; sb = 4; } else { isdn = 0; r = q - 224; sb = 4; }
        if (isdn) dn_scan_item(p, lds, sb + (r >> 3), (r & 7) >> 1, r & 1);
        else ssd_item(p, lds, sb + (r >> 4), (r & 15) >> 1, r & 1);
    }
    unsigned* cnt2 = (unsigned*)(p.ws + OFF_CNT) + 32;
    for (;;) {
        __syncthreads();
        if (threadIdx.x == 0) *slot = (int)atomicAdd(cnt2, 1u);
        __syncthreads();
        const int t = __builtin_amdgcn_readfirstlane(*slot);
        if (t >= 2368) break;
        weight_tile(p, lds, 960 + t);
    }
}

__device__ void phase_combine(const P& p) {
    const int tid = threadIdx.x;
    const u16* obuf = (const u16*)(p.ws + 5 * U); const u16* yf = (const u16*)((unsigned char*)p.out); const u16* yb = (const u16*)((unsigned char*)p.out + U);
    const u16* dnz = (const u16*)(p.ws + 8 * U); const u16* ssmz = (const u16*)(p.ws + 7 * U); u16* mix = (u16*)(p.ws + 2 * U);
    const int c8 = tid & 127; const bool isdn = c8 < 64;
    for (int rg = blockIdx.x; rg < NTOK / 16; rg += gridDim.x) {
        u32x4 la[4], lb[4], lz[4];
#pragma unroll
        for (int u = 0; u < 4; ++u) { const int R = rg * 16 + u * 4 + (tid >> 7);
            if (isdn) { const int h = c8 >> 4, e0 = (c8 & 15) * 8; const int chunk = R >> 6, i0 = R & 63;
                la[u] = *(const u32x4*)(obuf + (size_t)((chunk * 4 + h) * 2 + 0) * 8192 + i0 * 128 + e0);
                lb[u] = *(const u32x4*)(obuf + (size_t)((chunk * 4 + h) * 2 + 1) * 8192 + (63 - i0) * 128 + e0);
                lz[u] = *(const u32x4*)(dnz + (size_t)R * 512 + h * 128 + e0); }
            else { const int c = (c8 - 64) * 8; la[u] = *(const u32x4*)(yf + (size_t)R * 512 + c); lb[u] = *(const u32x4*)(yb + (size_t)R * 512 + c); lz[u] = *(const u32x4*)(ssmz + (size_t)R * 512 + c); } }
#pragma unroll
        for (int u = 0; u < 4; ++u) { const int R = rg * 16 + u * 4 + (tid >> 7);
            const u32x4 a = la[u], b = lb[u], z = lz[u];
            float v[8], zz[8];
            v[0] = blo(a.x) + blo(b.x); v[1] = bhi(a.x) + bhi(b.x); v[2] = blo(a.y) + blo(b.y); v[3] = bhi(a.y) + bhi(b.y);
            v[4] = blo(a.z) + blo(b.z); v[5] = bhi(a.z) + bhi(b.z); v[6] = blo(a.w) + blo(b.w); v[7] = bhi(a.w) + bhi(b.w);
            zz[0] = blo(z.x); zz[1] = bhi(z.x); zz[2] = blo(z.y); zz[3] = bhi(z.y); zz[4] = blo(z.z); zz[5] = bhi(z.z); zz[6] = blo(z.w); zz[7] = bhi(z.w);
            u16* dstp;
            if (isdn) { const int h = c8 >> 4, e0 = (c8 & 15) * 8;
                float ss = 0.f;
#pragma unroll
                for (int j = 0; j < 8; ++j) ss += v[j] * v[j];
                ss += __shfl_xor(ss, 1); ss += __shfl_xor(ss, 2); ss += __shfl_xor(ss, 4); ss += __shfl_xor(ss, 8);
                const float r = rsqrtf(ss * (1.f / 128.f) + 1e-6f);
#pragma unroll
                for (int j = 0; j < 8; ++j) v[j] = v[j] * r * p.dn_norm_w[e0 + j] * silu_f(zz[j]);
                dstp = mix + (size_t)R * 1024 + h * 128 + e0;
            } else { const int c = (c8 - 64) * 8;
                float ss = 0.f;
#pragma unroll
                for (int j = 0; j < 8; ++j) { v[j] *= silu_f(zz[j]); ss += v[j] * v[j]; }
                ss += __shfl_xor(ss, 1); ss += __shfl_xor(ss, 2); ss += __shfl_xor(ss, 4); ss += __shfl_xor(ss, 8); ss += __shfl_xor(ss, 16);
                const float r = rsqrtf(ss * (1.f / 256.f) + 1e-6f);
#pragma unroll
                for (int j = 0; j < 8; ++j) v[j] = v[j] * r * p.ssm_norm_w[c + j];
                dstp = mix + (size_t)R * 1024 + 512 + c; }
            u32x4 o; o.x = pk(v[0], v[1]); o.y = pk(v[2], v[3]); o.z = pk(v[4], v[5]); o.w = pk(v[6], v[7]);
            *(u32x4*)dstp = o; }
    }
}

__device__ void phase_ln(const P& p, const u16* src, const float* gam, const float* bet, u16* h2, u16* x1b) {
    const int tid = threadIdx.x, lane = tid & 63, wv = __builtin_amdgcn_readfirstlane(tid >> 6); const float* mod = (const float*)(p.ws + OFF_MOD);
    for (int R0 = (blockIdx.x * 8 + wv) * 4; R0 < NTOK; R0 += gridDim.x * 32) {
        u32x4 wl[4][2];
#pragma unroll
        for (int rr = 0; rr < 4; ++rr)
#pragma unroll
            for (int k = 0; k < 2; ++k) wl[rr][k] = *(const u32x4*)(src + (size_t)(R0 + rr) * 1024 + k * 512 + lane * 8);
        const int s = seq_of_row(R0);
#pragma unroll
        for (int rr = 0; rr < 4; ++rr) {
            const int R = R0 + rr;
            float v[16]; float sum = 0.f;
#pragma unroll
            for (int k = 0; k < 2; ++k) { const u32x4 w = wl[rr][k];
                v[k * 8 + 0] = blo(w.x); v[k * 8 + 1] = bhi(w.x); v[k * 8 + 2] = blo(w.y); v[k * 8 + 3] = bhi(w.y); v[k * 8 + 4] = blo(w.z); v[k * 8 + 5] = bhi(w.z); v[k * 8 + 6] = blo(w.w); v[k * 8 + 7] = bhi(w.w); }
#pragma unroll
            for (int j = 0; j < 16; ++j) sum += v[j];
#pragma unroll
            for (int o = 32; o >= 1; o >>= 1) sum += __shfl_xor(sum, o);
            const float mu = sum * (1.f / 1024.f); float q = 0.f;
#pragma unroll
            for (int j = 0; j < 16; ++j) { const float d = v[j] - mu; q += d * d; }
#pragma unroll
            for (int o = 32; o >= 1; o >>= 1) q += __shfl_xor(q, o);
            const float rstd = rsqrtf(q * (1.f / 1024.f) + 1e-5f);
            float* rp = p.out + (size_t)R * 1024;
#pragma unroll
            for (int k = 0; k < 2; ++k) { const int c = k * 512 + lane * 8; float o[8];
#pragma unroll
                for (int hq = 0; hq < 2; ++hq) { const f32x4 gv = *(const f32x4*)(gam + c + hq * 4), bv = *(const f32x4*)(bet + c + hq * 4); f32x4 ov;
#pragma unroll
                    for (int j = 0; j < 4; ++j) { ov[j] = (v[k * 8 + hq * 4 + j] - mu) * rstd * gv[j] + bv[j]; o[hq * 4 + j] = ov[j]; }
                    if (!x1b) *(f32x4*)(rp + c + hq * 4) = ov; }
                if (x1b) { u32x4 w; w.x = pk(o[0], o[1]); w.y = pk(o[2], o[3]); w.z = pk(o[4], o[5]); w.w = pk(o[6], o[7]); *(u32x4*)(x1b + (size_t)R * 1024 + c) = w; }
                if (h2) { const float* ms = mod + s * 6144 + c; float hv[8];
#pragma unroll
                    for (int hq = 0; hq < 2; ++hq) { const f32x4 sh = *(const f32x4*)(ms + 3072 + hq * 4), sc = *(const f32x4*)(ms + 4096 + hq * 4);
#pragma unroll
                        for (int j = 0; j < 4; ++j) hv[hq * 4 + j] = o[hq * 4 + j] * (1.f + sc[j]) + sh[j]; }
                    u32x4 w; w.x = pk(hv[0], hv[1]); w.y = pk(hv[2], hv[3]); w.z = pk(hv[4], hv[5]); w.w = pk(hv[6], hv[7]);
                    *(u32x4*)(h2 + (size_t)R * 1024 + c) = w; } }
        }
    }
}

__global__ void __launch_bounds__(512, 2) mega(P p, int ph_lo, int ph_hi, int coop) {
    extern __shared__ __attribute__((aligned(16))) unsigned char lds[];
    cg::grid_group grid = cg::this_grid();
    const int G = gridDim.x, bx = blockIdx.x;
    float* mod = (float*)(p.ws + OFF_MOD);
#ifndef PHASE_MASK
#define PHASE_MASK 0xfff
#endif
#define IN(k) (((PHASE_MASK >> (k)) & 1) && ph_lo <= (k) && (k) < ph_hi)
#define SEAM(k) do { if (coop && (k) + 1 < ph_hi) grid.sync(); } while (0)
    if (IN(0)) { phase_prep(p, lds); SEAM(0); }
    if (IN(1)) { __syncthreads(); phase_h1(p, lds); SEAM(1); }
    if (IN(2)) { __syncthreads();
        pg8::Gemm g{(const u16*)p.ws, (const u16*)(p.ws + OFF_WB1), NTOK, 3584, 1024}; pg8::StaticOrder S; S.init(NTOK, 3584, G, bx);
        EpiIn E{(u16*)(p.ws + 2 * U), (u16*)(p.ws + 8 * U), (u16*)(p.ws + 7 * U), (u16*)(p.ws + 5 * U), (float*)(p.ws + OFF_SMALL)};
        pg8::gemm_phase<EpiIn, pg8::StaticOrder>((LAS unsigned char*)lds, g, S, E); SEAM(2); }
    if (IN(3)) { __syncthreads(); phase_conv(p, lds); SEAM(3); }
    if (IN(4)) { __syncthreads(); phase_dnprep(p, lds); SEAM(4); }
    if (IN(5)) { phase_scan(p, lds); SEAM(5); }
    if (IN(6)) { phase_combine(p); SEAM(6); }
    if (IN(7)) { __syncthreads();
        pg8::Gemm g{(const u16*)(p.ws + 2 * U), (const u16*)(p.ws + OFF_WB2), NTOK, 1024, 1024}; pg8::StaticOrder S; S.init(NTOK, 1024, G, bx);
        EpiResT<true, false> E{p.x_prompt, p.x_sample, nullptr, p.out, (u16*)p.ws, mod + 2048};
        pg8::gemm_phase<EpiResT<true, false>, pg8::StaticOrder>((LAS unsigned char*)lds, g, S, E); SEAM(7); }
    if (IN(8)) { phase_ln(p, (const u16*)p.ws, p.ln1_g, p.ln1_b, (u16*)p.ws, (u16*)p.out); SEAM(8); }
    if (IN(9)) { __syncthreads();
        pg8::Gemm g{(const u16*)p.ws, (const u16*)(p.ws + OFF_WB3), NTOK, 5632, 1024}; pg8::StaticOrder S; S.init(NTOK, 5632, G, bx);
        EpiGLU E{(u16*)(p.ws + 2 * U)};
        pg8::gemm_phase<EpiGLU, pg8::StaticOrder>((LAS unsigned char*)lds, g, S, E); SEAM(9); }
    if (IN(10)) { __syncthreads();
        pg8::Gemm g{(const u16*)(p.ws + 2 * U), (const u16*)(p.ws + OFF_WB4), NTOK, 1024, 2816}; pg8::StaticOrder S; S.init(NTOK, 1024, G, bx);
        EpiResT<true, true> E{p.x_prompt, p.x_sample, (const u16*)p.out, p.out, (u16*)p.ws, mod + 5120};
        pg8::gemm_phase<EpiResT<true, true>, pg8::StaticOrder>((LAS unsigned char*)lds, g, S, E); SEAM(10); }
    if (IN(11)) { phase_ln(p, (const u16*)p.ws, p.ln2_g, p.ln2_b, nullptr, nullptr); }
#undef IN
#undef SEAM
}


#ifdef DIAG
constexpr size_t OFF_DIAG = WS_END;
__global__ void diag_cs(const unsigned* buf, size_t nwords, int isbf16, unsigned long long* cs, unsigned* nanf) {
    unsigned long long s = 0; unsigned bad = 0;
    for (size_t i = (size_t)blockIdx.x * blockDim.x + threadIdx.x; i < nwords; i += (size_t)gridDim.x * blockDim.x) { const unsigned w = buf[i]; s += w;
        if (isbf16) { if ((w & 0x7f80u) == 0x7f80u || (w & 0x7f800000u) == 0x7f800000u) bad = 1; } else if ((w & 0x7f800000u) == 0x7f800000u) bad = 1; }
    atomicAdd(cs, s); if (bad) atomicOr(nanf, 1u);
}
__global__ void diag_final(const unsigned long long* cs, const unsigned* nf, float* out, size_t n) {
    int m = 0, nn = 0;
    for (int b = 0; b < 5; ++b) { if (cs[40 + b] != cs[48 + 40 + b]) nn |= 1 << b; if (nf[40 + b] | nf[48 + 40 + b]) m |= 1 << b; }
    float c2 = (float)(10 + m) * 100.f; for (int i = 0; i < nn; ++i) c2 *= 10.f;
    const float c = sqrtf(c2);
    for (size_t i = (size_t)blockIdx.x * blockDim.x + threadIdx.x; i < n; i += (size_t)gridDim.x * blockDim.x) out[i] = c;
}
#endif
#ifndef N_LAUNCH_MODE
#define N_LAUNCH_MODE 1
#endif
extern "C" void kernel_launch(void* const* d_in, const int* in_sizes, int n_in, void* d_out, int out_size, void* d_ws, size_t ws_size, hipStream_t stream) {
    static int grid = 0;
    if (grid == 0) {
        if (n_in != 25 || out_size != NTOK * 1024 || ws_size < WS_END) { fprintf(stderr, "kernel_launch: unexpected shapes (n_in %d out %d ws %zu need %zu)\n", n_in, out_size, ws_size, (size_t)WS_END); grid = -1; return; }
        int dev = 0, cus = 0, per_cu = 0;
        hipGetDevice(&dev); hipDeviceGetAttribute(&cus, hipDeviceAttributeMultiprocessorCount, dev);
        if (hipFuncSetAttribute((const void*)mega, hipFuncAttributeMaxDynamicSharedMemorySize, LDS_BYTES) != hipSuccess) { fprintf(stderr, "kernel_launch: hipFuncSetAttribute failed\n"); grid = -1; return; }
        hipOccupancyMaxActiveBlocksPerMultiprocessor(&per_cu, (const void*)mega, 512, LDS_BYTES);
        if (per_cu < 1) { fprintf(stderr, "kernel_launch: occupancy query says %d blocks/CU\n", per_cu); per_cu = 1; }
        (void)hipGetLastError();
        grid = cus;
    }
    if (grid < 0) return;
    P p{};
    const float** pp = (const float**)&p;
    for (int i = 0; i < 25; ++i) pp[i] = (const float*)d_in[i];
    p.out = (float*)d_out; p.ws = (unsigned char*)d_ws;
#if N_LAUNCH_MODE == 1
    int lo = 0, hi = 12, coop = 1;
    void* args[] = {&p, &lo, &hi, &coop};
    hipError_t e = hipLaunchCooperativeKernel((const void*)mega, dim3(grid), dim3(512), args, LDS_BYTES, stream);
    if (e != hipSuccess) fprintf(stderr, "cooperative launch failed: %s (grid %d)\n", hipGetErrorString(e), grid);
#else
#ifdef DIAG
    unsigned char* ws = (unsigned char*)d_ws; unsigned char* ob = (unsigned char*)d_out;
    unsigned long long* cs = (unsigned long long*)(ws + OFF_DIAG); unsigned* nf = (unsigned*)(ws + OFF_DIAG + 2 * 48 * 8);
    hipMemsetAsync(ws + OFF_DIAG, 0, 2 * 48 * 8 + 2 * 48 * 4, stream);
    for (int run = 0; run < 2; ++run) for (int k = 0; k < 12; ++k) {
        hipLaunchKernelGGL(mega, dim3(grid), dim3(512), LDS_BYTES, stream, p, k, k + 1, 0);
        struct B { unsigned char* p; size_t bytes; int bf; } bl[4] = {{0,0,0},{0,0,0},{0,0,0},{0,0,0}};
        switch (k) {
            case 0: bl[0] = {ws + OFF_WB1, OFF_SMALL - OFF_WB1, 1}; bl[1] = {ws + OFF_MOD, 20 * 6144 * 4, 0}; break;
            case 1: bl[0] = {ws, 2 * U, 1}; break;
            case 2: bl[0] = {ws + 2 * U, 7 * U, 1}; bl[1] = {ws + OFF_SMALL, (size_t)NTOK * 32 * 4, 0}; break;
            case 3: bl[0] = {ws, 2 * U, 1}; bl[1] = {ws + 9 * U, U, 1}; bl[2] = {ob, 3 * U + U / 2, 1}; break;
            case 4: bl[0] = {ws + 2 * U, 5 * U, 1}; bl[1] = {ws + OFF_GCUM, (size_t)12288 * 64 * 4, 0}; bl[2] = {ob + 3 * U + U / 2, U / 2, 1};
                { struct B b5[5] = {{ws + 2 * U, 2 * U, 1}, {ws + 4 * U, U, 1}, {ws + 5 * U, 2 * U, 1}, {ws + OFF_GCUM, (size_t)12288 * 64 * 4, 0}, {ob + 3 * U + U / 2, U / 2, 1}};
                  for (int b = 0; b < 5; ++b) hipLaunchKernelGGL(diag_cs, dim3(2048), dim3(256), 0, stream, (const unsigned*)b5[b].p, b5[b].bytes / 4, b5[b].bf, cs + run * 48 + 40 + b, nf + run * 48 + 40 + b); }
                break;
            case 5: bl[0] = {ws + 5 * U, 2 * U, 1}; bl[1] = {ob, 2 * U, 1}; break;
            case 6: bl[0] = {ws + 2 * U, 2 * U, 1}; break;
            case 7: bl[0] = {ob, 4 * U, 0}; break;
            case 8: bl[0] = {ob, 4 * U, 0}; bl[1] = {ws, 2 * U, 1}; break;
            case 9: bl[0] = {ws + 2 * U, (size_t)NTOK * 2816 * 2, 1}; break;
            case 10: bl[0] = {ob, 4 * U, 0}; break;
            case 11: bl[0] = {ob, 4 * U, 0}; break;
        }
        for (int b = 0; b < 4; ++b) if (bl[b].p) hipLaunchKernelGGL(diag_cs, dim3(2048), dim3(256), 0, stream, (const unsigned*)bl[b].p, bl[b].bytes / 4, bl[b].bf, cs + run * 48 + k * 4 + b, nf + run * 48 + k * 4 + b);
    }
    hipLaunchKernelGGL(diag_final, dim3(2048), dim3(256), 0, stream, (const unsigned long long*)cs, (const unsigned*)nf, (float*)d_out, (size_t)NTOK * 1024);
#else
    for (int k = 0; k < 12; ++k) hipLaunchKernelGGL(mega, dim3(grid), dim3(512), LDS_BYTES, stream, p, k, k + 1, 0);
#endif
#endif
}
```

```cpp
#include <hip/hip_runtime.h>
#include <hip/hip_cooperative_groups.h>
#include <cstdio>

namespace cg = cooperative_groups;

#define LAS __attribute__((address_space(3)))
typedef unsigned short u16;
typedef short bf16x8 __attribute__((ext_vector_type(8)));
typedef float f32x4 __attribute__((ext_vector_type(4)));
typedef unsigned u32x4 __attribute__((ext_vector_type(4)));
typedef unsigned u32x2 __attribute__((ext_vector_type(2)));

constexpr int NTOK = 98304;
constexpr size_t U = (size_t)NTOK * 512 * 2;
constexpr size_t OFF_MISC = 10 * U;
constexpr size_t OFF_WB1 = OFF_MISC;
constexpr size_t OFF_WB2 = OFF_WB1 + (size_t)3840 * 1024 * 2;
constexpr size_t OFF_WB3 = OFF_WB2 + (size_t)1024 * 1024 * 2;
constexpr size_t OFF_WB4 = OFF_WB3 + (size_t)5632 * 1024 * 2;
constexpr size_t OFF_SMALL = OFF_WB4 + (size_t)1024 * 2816 * 2;
constexpr size_t OFF_MOD = OFF_SMALL + (size_t)NTOK * 32 * 4;
constexpr size_t OFF_GCUM = OFF_MOD + (size_t)20 * 6144 * 4;
constexpr size_t OFF_CNT = OFF_GCUM + (size_t)12288 * 128 * 4;
constexpr size_t WS_END = OFF_CNT + 256;
constexpr int LDS_BYTES = 163840;
constexpr float ALPHA = 1.189207115002721f;

struct P {
    const float *x_prompt, *x_sample, *c_prompt, *c_sample, *w_ada, *b_ada, *w_in, *dn_conv_w, *dn_A_log, *dn_dt_bias, *dn_norm_w,
        *ssm_conv_w, *ssm_conv_b, *ssm_A_log, *ssm_dt_bias, *ssm_D, *ssm_norm_w, *w_out, *ln1_g, *ln1_b, *w_gate, *w_up, *w_down, *ln2_g, *ln2_b;
    float* out; unsigned char* ws;
};

typedef __bf16 bf16v2 __attribute__((ext_vector_type(2)));
typedef float f32x2 __attribute__((ext_vector_type(2)));
__device__ __forceinline__ unsigned pk(float lo, float hi) { f32x2 v; v.x = lo; v.y = hi; bf16v2 b = __builtin_convertvector(v, bf16v2); return __builtin_bit_cast(unsigned, b); }
__device__ __forceinline__ u16 f2bf(float f) { return (u16)pk(f, f); }
__device__ __forceinline__ float bf2f(u16 b) { return __uint_as_float(((unsigned)b) << 16); }
__device__ __forceinline__ float blo(unsigned w) { return __uint_as_float(w << 16); }
__device__ __forceinline__ float bhi(unsigned w) { return __uint_as_float(w & 0xffff0000u); }
__device__ __forceinline__ float silu_f(float x) { return x * __builtin_amdgcn_rcpf(1.f + __expf(-x)); }
__device__ __forceinline__ float softplus_f(float x) { const float e = __expf(x); return x > 20.f ? x : (e < 1e-3f ? e * (1.f - 0.5f * e) : __logf(1.f + e)); }
__device__ __forceinline__ unsigned sw16(unsigned w) { return (w >> 16) | (w << 16); }
__device__ __forceinline__ u32x4 rev8(u32x4 v) { u32x4 o; o.x = sw16(v.w); o.y = sw16(v.z); o.z = sw16(v.y); o.w = sw16(v.x); return o; }
__device__ __forceinline__ bf16x8 asbf(u32x4 v) { return __builtin_bit_cast(bf16x8, v); }
__device__ __forceinline__ f32x4 mfma16(bf16x8 a, bf16x8 b, f32x4 c) { return __builtin_amdgcn_mfma_f32_16x16x32_bf16(a, b, c, 0, 0, 0); }
__device__ __forceinline__ void seq_info(int s, int& T, int& row0) { if (s < 4) { T = 8192; row0 = s * 8192; } else { T = 4096; row0 = 32768 + (s - 4) * 4096; } }
__device__ __forceinline__ int seq_of_row(int R) { return R < 32768 ? (R >> 13) : 4 + ((R - 32768) >> 12); }
__device__ __forceinline__ bf16x8 ldA2(const u16* p) { u32x2 lo = *(const u32x2*)p, hi = *(const u32x2*)(p + 16); u32x4 v; v.x = lo.x; v.y = lo.y; v.z = hi.x; v.w = hi.y; return asbf(v); }
__device__ __forceinline__ bf16x8 packB(f32x4 a, f32x4 b) { u32x4 v; v.x = pk(a[0], a[1]); v.y = pk(a[2], a[3]); v.z = pk(b[0], b[1]); v.w = pk(b[2], b[3]); return asbf(v); }

namespace pg8 {
constexpr int BM = 256, BK = 64, HALF = 128, HTB = HALF * BK * 2, STAGE_BYTES = 8 * HTB, NXCD = 8, WGM = 8;
__host__ __device__ __forceinline__ int lds_byte(int r, int c) { const int st = (r >> 4) * 2 + (c >> 5), rr = r & 15, cc = c & 31, ob = rr * 64 + cc * 2; return st * 1024 + (ob ^ (((ob >> 9) & 1) << 5)); }
__host__ __device__ __forceinline__ void stage_rc(int b, int& R, int& C) { const int st = b / 1024, sb = b % 1024, swz = sb ^ (((sb >> 9) & 1) << 5); R = (st >> 1) * 16 + swz / 64; C = (st & 1) * 32 + (swz % 64) / 2; }
__host__ __device__ __forceinline__ int perm32(int rho) { const int n = rho >> 4, i = rho & 15; return 8 * (i >> 2) + 4 * n + (i & 3); }
struct Unit { int pm, pn; };
struct Gemm { const u16* A; const u16* Bt; int M, N, K; };
struct StaticOrder {
    int nM, nN, nwg, G, c;
    __device__ void init(int M, int N, int G_, int c_) { nM = M / BM; nN = N / BM; nwg = nM * nN; G = G_; c = c_; }
    __device__ bool next(int i, Unit& u) const {
        const long L = (long)i * G + c; if (L >= nwg) return false;
        int wgid = (int)L; { const int q = nwg / NXCD, r = nwg % NXCD, xcd = wgid % NXCD, off = wgid / NXCD; wgid = (xcd < r ? xcd * (q + 1) : r * (q + 1) + (xcd - r) * q) + off; }
        const int nig = WGM * nN, gid = wgid / nig, fm = gid * WGM, gsz = (nM - fm) < WGM ? (nM - fm) : WGM;
        u.pm = fm + ((wgid % nig) % gsz); u.pn = (wgid % nig) / gsz; return true;
    }
    __device__ __forceinline__ void a_ready(const Unit&) const {}
    __device__ __forceinline__ void done(const Unit&) const {}
};

template <class Epi, class Sched>
__device__ __forceinline__ void gemm_phase(LAS unsigned char* lds, const Gemm g, const Sched& S, const Epi& E) {
    const int tid = threadIdx.x, wid = __builtin_amdgcn_readfirstlane(tid >> 6), lane = tid & 63, wr = wid >> 2, wc = wid & 3, fr = lane & 15, fq = lane >> 4;
    const int K = g.K, nt = K / BK;
    unsigned voffA[2], voffB[2];
#pragma unroll
    for (int i = 0; i < 2; ++i) { int R, C; stage_rc(tid * 16 + i * 8192, R, C); const int Rb = Epi::PERM ? ((R & ~31) + perm32(R & 31)) : R;
        voffA[i] = (unsigned)(R * K + C) * 2u; voffB[i] = (unsigned)(Rb * K + C) * 2u; }
    const size_t kstep = (size_t)(BK * 2);
    const size_t hstep = (size_t)HALF * K * 2;
    const size_t tstep = 2 * hstep;
    const unsigned ldsw = (unsigned)wid * 1024u;
    const int aoff = lds_byte(wr * 64 + fr, fq * 8), boff = lds_byte(wc * 32 + fr, fq * 8);
#define PG8_SA(b, h) (((b) * 2 + (h)) * HTB)
#define PG8_SB(b, h) ((4 + (b) * 2 + (h)) * HTB)
#define PG8_STAGE(bufoff, gbase, voff) do { _Pragma("unroll") for (int _i = 0; _i < 2; ++_i) \
        __builtin_amdgcn_global_load_lds((const unsigned*)((const char*)(gbase) + (voff)[_i]), (LAS unsigned*)(lds + (bufoff) + ldsw + _i * 8192), 16, 0, 0); } while (0)
#define PG8_LDA(dst, b, h) do { _Pragma("unroll") for (int m = 0; m < 4; ++m) _Pragma("unroll") for (int k = 0; k < 2; ++k) dst[m][k] = *(const LAS bf16x8*)(lds + PG8_SA(b, h) + aoff + m * 2048 + k * 1024); } while (0)
#define PG8_LDB(dst, b, h) do { _Pragma("unroll") for (int n = 0; n < 2; ++n) _Pragma("unroll") for (int k = 0; k < 2; ++k) dst[n][k] = *(const LAS bf16x8*)(lds + PG8_SB(b, h) + boff + n * 2048 + k * 1024); } while (0)
#define PG8_MMA(ai, bj, At, Bt) do { __builtin_amdgcn_s_setprio(1); _Pragma("unroll") for (int m = 0; m < 4; ++m) _Pragma("unroll") for (int n = 0; n < 2; ++n) _Pragma("unroll") for (int k = 0; k < 2; ++k) \
        acc[ai][bj][m][n] = __builtin_amdgcn_mfma_f32_16x16x32_bf16(Bt[n][k], At[m][k], acc[ai][bj][m][n], 0, 0, 0); __builtin_amdgcn_s_setprio(0); } while (0)
#define PG8_WAIT_V(n) asm volatile("s_waitcnt vmcnt(" #n ")" ::: "memory")
#define PG8_WAIT_L(n) asm volatile("s_waitcnt lgkmcnt(" #n ")" ::: "memory")
#define PG8_BAR __builtin_amdgcn_s_barrier()
#define PG8_SCHED __builtin_amdgcn_sched_barrier(0)
    Unit cur, nxt; int ui = 0;
    if (!S.next(0, cur)) return;
    f32x4 acc[2][2][4][2];
#pragma unroll
    for (int a = 0; a < 2; ++a)
#pragma unroll
        for (int b = 0; b < 2; ++b)
#pragma unroll
            for (int m = 0; m < 4; ++m)
#pragma unroll
                for (int n = 0; n < 2; ++n) acc[a][b][m][n] = (f32x4){0.f, 0.f, 0.f, 0.f};
    bf16x8 At[4][2], B0[2][2], B1[2][2];
    const char* cA = (const char*)g.A + (size_t)cur.pm * tstep; const char* cB = (const char*)g.Bt + (size_t)cur.pn * tstep;
    S.a_ready(cur);
    PG8_STAGE(PG8_SB(0, 0), cB, voffB); PG8_STAGE(PG8_SA(0, 0), cA, voffA); PG8_STAGE(PG8_SB(0, 1), cB + hstep, voffB); PG8_STAGE(PG8_SA(0, 1), cA + hstep, voffA);
    if (wr == 1) PG8_BAR;
    PG8_WAIT_V(4); PG8_BAR;
    PG8_STAGE(PG8_SB(1, 0), cB + kstep, voffB); PG8_STAGE(PG8_SA(1, 0), cA + kstep, voffA); PG8_STAGE(PG8_SB(1, 1), cB + hstep + kstep, voffB);
    PG8_WAIT_V(6); PG8_BAR;
    for (;;) {
        const bool has_next = S.next(ui + 1, nxt);
        const char* nA = has_next ? (const char*)g.A + (size_t)nxt.pm * tstep : cA; const char* nB = has_next ? (const char*)g.Bt + (size_t)nxt.pn * tstep : cB;
        for (int t = 0; t < nt; t += 2) {
            const bool last = (t == nt - 2);
            const char* a1 = cA + (size_t)(t + 1) * kstep;
            const char* a2 = last ? nA : cA + (size_t)(t + 2) * kstep; const char* b2 = last ? nB : cB + (size_t)(t + 2) * kstep;
            const char* a3 = a2 + kstep; const char* b3 = b2 + kstep;
            if (last && has_next) S.a_ready(nxt);
            PG8_LDB(B0, 0, 0); PG8_SCHED; PG8_LDA(At, 0, 0); PG8_STAGE(PG8_SA(1, 1), a1 + hstep, voffA);
            PG8_WAIT_L(8); PG8_BAR; PG8_WAIT_L(0); PG8_MMA(0, 0, At, B0); PG8_BAR; PG8_SCHED;
            PG8_LDB(B1, 0, 1); PG8_STAGE(PG8_SB(0, 0), b2, voffB);
            PG8_BAR; PG8_WAIT_L(0); PG8_MMA(0, 1, At, B1); PG8_BAR;
            PG8_LDA(At, 0, 1); PG8_STAGE(PG8_SA(0, 0), a2, voffA);
            PG8_BAR; PG8_WAIT_L(0); PG8_MMA(1, 0, At, B0); PG8_BAR; PG8_SCHED;
            PG8_STAGE(PG8_SB(0, 1), b2 + hstep, voffB);
            PG8_WAIT_V(6); PG8_BAR; PG8_MMA(1, 1, At, B1); PG8_BAR;
            PG8_LDB(B0, 1, 0); PG8_SCHED; PG8_LDA(At, 1, 0); PG8_STAGE(PG8_SA(0, 1), a2 + hstep, voffA);
            PG8_WAIT_L(8); PG8_BAR; PG8_WAIT_L(0); PG8_MMA(0, 0, At, B0); PG8_BAR; PG8_SCHED;
            PG8_LDB(B1, 1, 1); PG8_STAGE(PG8_SB(1, 0), b3, voffB);
            PG8_BAR; PG8_WAIT_L(0); PG8_MMA(0, 1, At, B1); PG8_BAR;
            PG8_LDA(At, 1, 1); PG8_STAGE(PG8_SA(1, 0), a3, voffA);
            PG8_BAR; PG8_WAIT_L(0); PG8_MMA(1, 0, At, B0); PG8_BAR; PG8_SCHED;
            PG8_STAGE(PG8_SB(1, 1), b3 + hstep, voffB);
            PG8_WAIT_V(6); PG8_BAR; PG8_MMA(1, 1, At, B1); PG8_BAR;
        }
        E(acc, cur, wr, wc, fr, fq); S.done(cur);
        if (!has_next) break;
#pragma unroll
        for (int a = 0; a < 2; ++a)
#pragma unroll
            for (int b = 0; b < 2; ++b)
#pragma unroll
                for (int m = 0; m < 4; ++m)
#pragma unroll
                    for (int n = 0; n < 2; ++n) acc[a][b][m][n] = (f32x4){0.f, 0.f, 0.f, 0.f};
        cur = nxt; cA = nA; cB = nB; ++ui;
    }
    PG8_WAIT_V(0);
    if (wr == 0) PG8_BAR;
    PG8_BAR;
#undef PG8_SA
#undef PG8_SB
#undef PG8_STAGE
#undef PG8_LDA
#undef PG8_LDB
#undef PG8_MMA
#undef PG8_WAIT_V
#undef PG8_WAIT_L
#undef PG8_BAR
#undef PG8_SCHED
}
}

struct EpiIn {
    static constexpr bool PERM = true;
    u16 *qkv, *dnz, *ssmz, *xbc; float* small;
    __device__ __forceinline__ void operator()(const f32x4 (&acc)[2][2][4][2], const pg8::Unit& u, int wr, int wc, int fr, int fq) const {
        const int row0 = u.pm * 256 + wr * 64 + fr; const int pn = u.pn;
        if (pn < 14) {
            u16* base; int ld, colt;
            if (pn < 6) { base = qkv; ld = 1536; colt = pn * 256; }
            else if (pn < 8) { base = dnz; ld = 512; colt = (pn - 6) * 256; }
            else if (pn < 10) { base = ssmz; ld = 512; colt = (pn - 8) * 256; }
            else { base = xbc; ld = 1024; colt = (pn - 10) * 256; }
            const int col0 = colt + wc * 32 + 8 * fq;
#pragma unroll
            for (int ai = 0; ai < 2; ++ai)
#pragma unroll
                for (int m = 0; m < 4; ++m) { u16* rowp = base + (size_t)(row0 + ai * 128 + m * 16) * ld + col0;
#pragma unroll
                    for (int bj = 0; bj < 2; ++bj) { const f32x4 v0 = acc[ai][bj][m][0], v1 = acc[ai][bj][m][1];
                        u32x4 w; w.x = pk(v0[0], v0[1]); w.y = pk(v0[2], v0[3]); w.z = pk(v1[0], v1[1]); w.w = pk(v1[2], v1[3]);
                        *(u32x4*)(rowp + bj * 128) = w; } }
        } else if (wc == 0) {
#pragma unroll
            for (int ai = 0; ai < 2; ++ai)
#pragma unroll
                for (int m = 0; m < 4; ++m) { float* rp = small + (size_t)(row0 + ai * 128 + m * 16) * 32 + 8 * fq;
                    *(f32x4*)rp = acc[ai][0][m][0]; *(f32x4*)(rp + 4) = acc[ai][0][m][1]; }
        }
    }
};
template <bool BF, bool XBF> struct EpiResT {
    static constexpr bool PERM = false;
    const float* xp; const float* xs; const u16* xb; float* out; u16* outb; const float* gate;
    __device__ __forceinline__ void operator()(const f32x4 (&acc)[2][2][4][2], const pg8::Unit& u, int wr, int wc, int fr, int fq) const {
        const int rowt = u.pm * 256; const int s = seq_of_row(rowt); const float* g = gate + s * 6144;
        const int row0 = rowt + wr * 64 + fr, col0 = u.pn * 256 + wc * 32 + 4 * fq;
        f32x4 gv[2][2];
#pragma unroll
        for (int bj = 0; bj < 2; ++bj)
#pragma unroll
            for (int n = 0; n < 2; ++n) gv[bj][n] = *(const f32x4*)(g + col0 + bj * 128 + n * 16);
#pragma unroll
        for (int ai = 0; ai < 2; ++ai)
#pragma unroll
            for (int m = 0; m < 4; ++m) { const int R = row0 + ai * 128 + m * 16;
                const float* xr = (R < 32768 ? xp + (size_t)R * 1024 : xs + (size_t)(R - 32768) * 1024) + col0;
#pragma unroll
                for (int bj = 0; bj < 2; ++bj)
#pragma unroll
                    for (int n = 0; n < 2; ++n) { f32x4 xv; if (XBF) { const u32x2 xw = *(const u32x2*)(xb + (size_t)R * 1024 + col0 + bj * 128 + n * 16); xv[0] = blo(xw.x); xv[1] = bhi(xw.x); xv[2] = blo(xw.y); xv[3] = bhi(xw.y); } else xv = *(const f32x4*)(xr + bj * 128 + n * 16);
                        const f32x4 y = ALPHA * xv + gv[bj][n] * acc[ai][bj][m][n];
                        if (BF) { u32x2 w; w.x = pk(y[0], y[1]); w.y = pk(y[2], y[3]); *(u32x2*)(outb + (size_t)R * 1024 + col0 + bj * 128 + n * 16) = w; }
                        else *(f32x4*)(out + (size_t)R * 1024 + col0 + bj * 128 + n * 16) = y; }
                asm volatile("" ::: "memory"); }
    }
};
struct EpiGLU {
    static constexpr bool PERM = true;
    u16* act;
    __device__ __forceinline__ void operator()(const f32x4 (&acc)[2][2][4][2], const pg8::Unit& u, int wr, int wc, int fr, int fq) const {
        const int row0 = u.pm * 256 + wr * 64 + fr, ff0 = u.pn * 128 + wc * 32 + 8 * fq;
#pragma unroll
        for (int ai = 0; ai < 2; ++ai)
#pragma unroll
            for (int m = 0; m < 4; ++m) { u16* rp = act + (size_t)(row0 + ai * 128 + m * 16) * 2816 + ff0; float v[8];
#pragma unroll
                for (int n = 0; n < 2; ++n) { const f32x4 gt = acc[ai][0][m][n], up = acc[ai][1][m][n];
#pragma unroll
                    for (int j = 0; j < 4; ++j) v[n * 4 + j] = silu_f(gt[j]) * up[j]; }
                u32x4 w; w.x = pk(v[0], v[1]); w.y = pk(v[2], v[3]); w.z = pk(v[4], v[5]); w.w = pk(v[6], v[7]); *(u32x4*)rp = w; }
    }
};

__device__ __forceinline__ int map_in_col(int n) { if (n < 2048) return n; if (n < 3584) return n + 16; if (n < 3600) return 2048 + (n - 3584); if (n < 3616) return n; return -1; }
__device__ void weight_tile(const P& p, unsigned char* lds, int t) {
    const int tid = threadIdx.x; float* tile = (float*)lds;
    int which, nt, kt, K; u16* dst;
    if (t < 960) { which = 1; nt = t / 16; kt = t % 16; K = 1024; dst = (u16*)(p.ws + OFF_WB1); }
    else if (t < 1216) { which = 2; nt = (t - 960) / 16; kt = (t - 960) % 16; K = 1024; dst = (u16*)(p.ws + OFF_WB2); }
    else if (t < 2624) { which = 3; nt = (t - 1216) / 16; kt = (t - 1216) % 16; K = 1024; dst = (u16*)(p.ws + OFF_WB3); }
    else { which = 4; nt = (t - 2624) / 44; kt = (t - 2624) % 44; K = 2816; dst = (u16*)(p.ws + OFF_WB4); }
    const int n0 = nt * 64, k0 = kt * 64;
    for (int e = tid; e < 4096; e += 512) { const int kk = e >> 6, nn = e & 63, n = n0 + nn; const size_t k = (size_t)(k0 + kk); float v;
        if (which == 1) { const int col = map_in_col(n); v = col >= 0 ? p.w_in[k * 3616 + col] : 0.f; }
        else if (which == 2) v = p.w_out[k * 1024 + n];
        else if (which == 3) { const int ff = (n >> 8) * 128 + (n & 127); v = ((n >> 7) & 1) ? p.w_up[k * 2816 + ff] : p.w_gate[k * 2816 + ff]; }
        else v = p.w_down[k * 1024 + n];
        tile[kk * 65 + nn] = v; }
    __syncthreads();
    for (int e = tid; e < 4096; e += 512) { const int nn = e >> 6, kk = e & 63; dst[(size_t)(n0 + nn) * K + k0 + kk] = f2bf(tile[kk * 65 + nn]); }
    __syncthreads();
}
__device__ void phase_prep(const P& p, unsigned char* lds) {
    const int tid = threadIdx.x;
    float* fl = (float*)lds;
    if (blockIdx.x == 0 && tid < 64) ((unsigned*)(p.ws + OFF_CNT))[tid] = 0u;
    float* mod = (float*)(p.ws + OFF_MOD);
    if (blockIdx.x < 96) {
        float* sc = fl; float* red = fl + 20 * 1024;
        for (int e = tid; e < 20 * 1024; e += 512) { const int b = e >> 10, k = e & 1023; const float c = b < 4 ? p.c_prompt[b * 1024 + k] : p.c_sample[(b - 4) * 1024 + k]; sc[e] = silu_f(c); }
        __syncthreads();
        const int kg = tid >> 6, jj = tid & 63, j = blockIdx.x * 64 + jj;
        float acc[20];
#pragma unroll
        for (int b = 0; b < 20; ++b) acc[b] = 0.f;
        for (int k = kg * 128; k < kg * 128 + 128; ++k) { const float wv = p.w_ada[(size_t)k * 6144 + j];
#pragma unroll
            for (int b = 0; b < 20; ++b) acc[b] += sc[b * 1024 + k] * wv; }
#pragma unroll
        for (int b = 0; b < 20; ++b) red[(kg * 20 + b) * 64 + jj] = acc[b];
        __syncthreads();
        for (int e = tid; e < 1280; e += 512) { const int b = e >> 6, j2 = e & 63; float s = p.b_ada[blockIdx.x * 64 + j2];
#pragma unroll
            for (int k2 = 0; k2 < 8; ++k2) s += red[(k2 * 20 + b) * 64 + j2];
            mod[b * 6144 + blockIdx.x * 64 + j2] = s; }
        __syncthreads();
    }
    for (int t = blockIdx.x; t < 960; t += gridDim.x) weight_tile(p, lds, t);
}

__device__ void phase_h1(const P& p, unsigned char* lds) {
    const int tid = threadIdx.x, lane = tid & 63, wv = __builtin_amdgcn_readfirstlane(tid >> 6), fr = lane & 15, g4 = lane >> 4;
    const float* mod = (const float*)(p.ws + OFF_MOD); u16* h1 = (u16*)(p.ws); float* small = (float*)(p.ws + OFF_SMALL);
    const u16* Wb1 = (const u16*)(p.ws + OFF_WB1); u16* LW = (u16*)lds;
    for (int pc = tid; pc < 4096; pc += 512) { const int n = pc >> 7, c8 = pc & 127; *(u32x4*)(LW + n * 1032 + c8 * 8) = *(const u32x4*)(Wb1 + (size_t)(3584 + n) * 1024 + c8 * 8); }
    __syncthreads();
    for (int tile = blockIdx.x * 8 + wv; tile < NTOK / 16; tile += gridDim.x * 8) {
        const int R = tile * 16 + fr; const int s = seq_of_row(tile * 16);
        const float* xr = (R < 32768 ? p.x_prompt + (size_t)R * 1024 : p.x_sample + (size_t)(R - 32768) * 1024) + g4 * 8;
        const float* m = mod + s * 6144 + g4 * 8; u16* hr = h1 + (size_t)R * 1024 + g4 * 8;
        f32x4 acc0 = (f32x4){0.f, 0.f, 0.f, 0.f}, acc1 = (f32x4){0.f, 0.f, 0.f, 0.f};
#pragma unroll 4
        for (int ks = 0; ks < 32; ++ks) {
            const f32x4 a = *(const f32x4*)(xr + ks * 32), b = *(const f32x4*)(xr + ks * 32 + 4);
            const f32x4 sh0 = *(const f32x4*)(m + ks * 32), sh1 = *(const f32x4*)(m + ks * 32 + 4), sc0 = *(const f32x4*)(m + 1024 + ks * 32), sc1 = *(const f32x4*)(m + 1028 + ks * 32);
            const f32x4 o0 = a * (1.f + sc0) + sh0, o1 = b * (1.f + sc1) + sh1;
            u32x4 w; w.x = pk(o0[0], o0[1]); w.y = pk(o0[2], o0[3]); w.z = pk(o1[0], o1[1]); w.w = pk(o1[2], o1[3]);
            *(u32x4*)(hr + ks * 32) = w;
            const bf16x8 af = asbf(w);
            const bf16x8 b0 = *(const bf16x8*)(LW + fr * 1032 + ks * 32 + g4 * 8), b1 = *(const bf16x8*)(LW + (16 + fr) * 1032 + ks * 32 + g4 * 8);
            acc0 = mfma16(af, b0, acc0); acc1 = mfma16(af, b1, acc1);
        }
#pragma unroll
        for (int r = 0; r < 4; ++r) { float* sp = small + (size_t)(tile * 16 + 4 * g4 + r) * 32 + fr; sp[0] = acc0[r]; sp[16] = acc1[r]; }
    }
}

__device__ void phase_conv(const P& p, unsigned char* lds) {
    const u16* Pqkv = (const u16*)(p.ws + 2 * U); const u16* Pxbc = (const u16*)(p.ws + 5 * U);
    u16* Cq = (u16*)(p.ws + 9 * U); u16* Ck = (u16*)((unsigned char*)p.out); u16* vT = (u16*)((unsigned char*)p.out + U); u16* kT = (u16*)((unsigned char*)p.out + 2 * U);
    u16* xT = (u16*)(p.ws); u16* BmT = (u16*)(p.ws + U); u16* Bm = (u16*)(p.ws + U + U / 2); u16* Cm = (u16*)((unsigned char*)p.out + 3 * U);
    u16* LT = (u16*)lds;
    const int tid0 = threadIdx.x;
    for (int bi = blockIdx.x; bi < 768 * 5; bi += gridDim.x) {
        int tid = tid0; asm volatile("" : "+v"(tid));
        const int cgl = tid & 63, tb = tid >> 6;
        const int tile = bi / 5, cb = bi - tile * 5;
        const int Rt = tile * 128; const int s = seq_of_row(Rt); int T, row0; seq_info(s, T, row0); const int tt0 = Rt - row0;
        const bool dn = cb < 3; const int c = (dn ? cb * 512 : (cb - 3) * 512) + cgl * 8; const int cl = cgl * 8;
        const u16* src = dn ? Pqkv : Pxbc; const int ld = dn ? 1536 : 1024; const float* cw = dn ? p.dn_conv_w : p.ssm_conv_w;
        float w[5][8];
#pragma unroll
        for (int i = 0; i < 5; ++i) { const f32x4 a = *(const f32x4*)(cw + i * ld + c), b = *(const f32x4*)(cw + i * ld + c + 4);
#pragma unroll
            for (int j = 0; j < 4; ++j) { w[i][j] = a[j]; w[i][4 + j] = b[j]; } }
        float bias[8];
#pragma unroll
        for (int j = 0; j < 8; ++j) bias[j] = dn ? 0.f : p.ssm_conv_b[c + j];
        const bool has_tr = (cb == 1) || (cb == 2) || (cb == 3) || (cb == 4 && cl < 256);
#pragma unroll 1
        for (int half = 0; half < 2; ++half) {
            const int tblk = tb + half * 8;
            const int t0 = tt0 + tblk * 8; const int R0 = row0 + t0;
            float acc[8][8];
#pragma unroll
            for (int tt = 0; tt < 8; ++tt)
#pragma unroll
                for (int j = 0; j < 8; ++j) acc[tt][j] = bias[j];
#pragma unroll
            for (int r = 0; r < 12; ++r) { const int t = t0 + r - 2;
                u32x4 v = (u32x4){0u, 0u, 0u, 0u};
                if (t >= 0 && t < T) v = *(const u32x4*)(src + (size_t)(row0 + t) * ld + c);
                float f[8]; f[0] = blo(v.x); f[1] = bhi(v.x); f[2] = blo(v.y); f[3] = bhi(v.y); f[4] = blo(v.z); f[5] = bhi(v.z); f[6] = blo(v.w); f[7] = bhi(v.w);
#pragma unroll
                for (int i = 0; i < 5; ++i) { const int tt = r - i; if (tt >= 0 && tt < 8) {
#pragma unroll
                    for (int j = 0; j < 8; ++j) acc[tt][j] += w[i][j] * f[j]; } } }
#pragma unroll
            for (int tt = 0; tt < 8; ++tt)
#pragma unroll
                for (int j = 0; j < 8; ++j) acc[tt][j] = silu_f(acc[tt][j]);
            if (cb < 2) {
#pragma unroll
                for (int tt = 0; tt < 8; ++tt) { float ss = 0.f;
#pragma unroll
                    for (int j = 0; j < 8; ++j) ss += acc[tt][j] * acc[tt][j];
                    ss += __shfl_xor(ss, 1); ss += __shfl_xor(ss, 2); ss += __shfl_xor(ss, 4); ss += __shfl_xor(ss, 8);
                    float sc = rsqrtf(ss + 1e-6f); if (cb == 0) sc *= 0.08838834764831845f;
#pragma unroll
                    for (int j = 0; j < 8; ++j) acc[tt][j] *= sc; }
            }
            u16* rm = nullptr; int rld = 0, rc = 0;
            if (cb == 0) { rm = Cq; rld = 512; rc = cl; } else if (cb == 1) { rm = Ck; rld = 512; rc = cl; }
            else if (cb == 4) { if (cl >= 256) { rm = Cm; rld = 256; rc = cl - 256; } else { rm = Bm; rld = 256; rc = cl; } }
            if (rm) {
#pragma unroll
                for (int tt = 0; tt < 8; ++tt) { u32x4 o; o.x = pk(acc[tt][0], acc[tt][1]); o.y = pk(acc[tt][2], acc[tt][3]); o.z = pk(acc[tt][4], acc[tt][5]); o.w = pk(acc[tt][6], acc[tt][7]);
                    *(u32x4*)(rm + (size_t)(R0 + tt) * rld + rc) = o; }
            }
            if (has_tr) {
#pragma unroll
                for (int j = 0; j < 8; ++j) { u32x4 o; o.x = pk(acc[0][j], acc[1][j]); o.y = pk(acc[2][j], acc[3][j]); o.z = pk(acc[4][j], acc[5][j]); o.w = pk(acc[6][j], acc[7][j]);
                    *(u32x4*)(LT + (cl + j) * 136 + tblk * 8) = o; }
            }
        }
        if (cb != 0) {
            __syncthreads();
            u16* tr; int tw, nrows;
            if (cb == 1) { tr = kT; tw = 512; nrows = 512; } else if (cb == 2) { tr = vT; tw = 512; nrows = 512; } else if (cb == 3) { tr = xT; tw = 512; nrows = 512; } else { tr = BmT; tw = 256; nrows = 256; }
            for (int q = tid; q < nrows * 16; q += 512) { const int row = q >> 4, ch = q & 15;
                u16* dstp = (cb <= 2) ? tr + ((size_t)((Rt >> 6) + (ch >> 3)) * 512 + row) * 64 + (ch & 7) * 8
                                      : tr + ((size_t)(Rt >> 7) * tw + row) * 128 + ch * 8;
                *(u32x4*)dstp = *(const u32x4*)(LT + row * 136 + ch * 8); }
            __syncthreads();
        }
    }
}

__device__ void phase_dnprep(const P& p, unsigned char* lds) {
    const int tid = threadIdx.x, lane0 = tid & 63, wv = __builtin_amdgcn_readfirstlane(tid >> 6);
    const u16* Cq = (const u16*)(p.ws + 9 * U); const u16* Ck = (const u16*)((unsigned char*)p.out); const u16* vT = (const u16*)((unsigned char*)p.out + U); const u16* kT = (const u16*)((unsigned char*)p.out + 2 * U);
    u16* wbuf = (u16*)(p.ws + 2 * U); u16* attn = (u16*)(p.ws + 4 * U); u16* ubuf = (u16*)(p.ws + 5 * U);
    const float* small = (const float*)(p.ws + OFF_SMALL); float* gcum = (float*)(p.ws + OFF_GCUM);
    float* Lw = (float*)(lds + wv * 17408);
    for (int unit = blockIdx.x * 8 + wv; unit < 12288; unit += gridDim.x * 8) {
        int lane = lane0; asm volatile("" : "+v"(lane));
        const int fr = lane & 15, g4 = lane >> 4;
        const int dir = unit & 1, h = (unit >> 1) & 3, chunk = unit >> 3; const int Rc = chunk * 64;
        const int s = seq_of_row(Rc); int T, row0; seq_info(s, T, row0);
        const int Ri = Rc + (dir ? 63 - lane : lane);
        const float a_raw = small[(size_t)Ri * 32 + dir * 4 + h], b_raw = small[(size_t)Ri * 32 + 8 + dir * 4 + h];
        bf16x8 kf[4][4], qf[4][4];
        const int vr0 = dir ? 63 - fr : fr, vstep = dir ? -16 : 16;
        const u16* kp = Ck + (size_t)(Rc + vr0) * 512 + h * 128 + g4 * 8; const u16* qp = Cq + (size_t)(Rc + vr0) * 512 + h * 128 + g4 * 8;
#pragma unroll
        for (int it = 0; it < 4; ++it) {
#pragma unroll
            for (int ks = 0; ks < 4; ++ks) { kf[it][ks] = *(const bf16x8*)(kp + it * vstep * 512 + ks * 32); qf[it][ks] = *(const bf16x8*)(qp + it * vstep * 512 + ks * 32); } }
        const float gl = -__expf(p.dn_A_log[dir * 4 + h]) * softplus_f(a_raw + p.dn_dt_bias[dir * 4 + h]);
        const float beta = __builtin_amdgcn_rcpf(1.f + __expf(-b_raw));
        float g = gl;
#pragma unroll
        for (int o = 1; o < 64; o <<= 1) { const float t = __shfl_up(g, o); if (lane >= o) g += t; }
        { const float glast = __shfl(g, 63); gcum[(size_t)unit * 128 + lane] = __expf(g); gcum[(size_t)unit * 128 + 64 + lane] = __expf(glast - g); }
        float gj[4];
#pragma unroll
        for (int jt = 0; jt < 4; ++jt) gj[jt] = __shfl(g, jt * 16 + fr);
#pragma unroll
        for (int it = 0; it < 4; ++it) {
            float gi[4], bi[4];
#pragma unroll
            for (int r = 0; r < 4; ++r) { gi[r] = __shfl(g, it * 16 + 4 * g4 + r); bi[r] = __shfl(beta, it * 16 + 4 * g4 + r); }
#pragma unroll
            for (int jt = 0; jt < 4; ++jt) {
                float av[4] = {0.f, 0.f, 0.f, 0.f};
                if (jt <= it) {
                    f32x4 kk = (f32x4){0.f, 0.f, 0.f, 0.f}, qk = (f32x4){0.f, 0.f, 0.f, 0.f};
#pragma unroll
                    for (int ks = 0; ks < 4; ++ks) { kk = mfma16(kf[it][ks], kf[jt][ks], kk); qk = mfma16(qf[it][ks], kf[jt][ks], qk); }
#pragma unroll
                    for (int r = 0; r < 4; ++r) { const int i = it * 16 + 4 * g4 + r, j = jt * 16 + fr; const float dec = __expf(fminf(gi[r] - gj[jt], 0.f));
                        Lw[i * 68 + j] = (j < i) ? bi[r] * kk[r] * dec : 0.f; av[r] = (j <= i) ? qk[r] * dec : 0.f; }
                }
#pragma unroll
                for (int r = 0; r < 4; ++r) attn[(size_t)unit * 4096 + (it * 16 + 4 * g4 + r) * 64 + jt * 16 + fr] = f2bf(av[r]);
                __builtin_amdgcn_sched_barrier(0);
            }
        }
        u32x4 AF[2][8][2];
#pragma unroll
        for (int mat = 0; mat < 2; ++mat) { const u16* srcT = (mat ? vT : kT) + ((size_t)chunk * 512 + h * 128) * 64;
#pragma unroll
            for (int dt = 0; dt < 8; ++dt)
#pragma unroll
                for (int ks = 0; ks < 2; ++ks) { const int joff = dir ? (56 - ks * 32 - g4 * 8) : (ks * 32 + g4 * 8); AF[mat][dt][ks] = *(const u32x4*)(srcT + (dt * 16 + fr) * 64 + joff); } }
        asm volatile("s_waitcnt lgkmcnt(0)" ::: "memory");
        { const int bb = lane >> 4, cc = lane & 15; float* Ld = Lw + (16 * bb) * 68 + 16 * bb;
          float d[16];
#pragma unroll
          for (int i = 0; i < 16; ++i) { float acc = (cc == i) ? 1.f : 0.f;
#pragma unroll
              for (int j4 = 0; j4 < i; j4 += 4) { const f32x4 l4 = *(const f32x4*)(Ld + i * 68 + j4);
                  acc -= l4[0] * d[j4]; if (j4 + 1 < i) acc -= l4[1] * d[j4 + 1]; if (j4 + 2 < i) acc -= l4[2] * d[j4 + 2]; if (j4 + 3 < i) acc -= l4[3] * d[j4 + 3]; }
              d[i] = acc; }
          asm volatile("s_waitcnt lgkmcnt(0)" ::: "memory");
#pragma unroll
          for (int i = 0; i < 16; ++i) Ld[i * 68 + cc] = d[i]; }
        asm volatile("s_waitcnt lgkmcnt(0)" ::: "memory");
#pragma unroll
        for (int J = 0; J < 3; ++J)
#pragma unroll
            for (int I = J + 1; I < 4; ++I) {
                f32x4 X = (f32x4){0.f, 0.f, 0.f, 0.f};
#pragma unroll
                for (int K = J; K < I; ++K)
#pragma unroll
                    for (int q = 0; q < 4; ++q) { const float av = Lw[(16 * I + fr) * 68 + 16 * K + 4 * q + g4], bv = Lw[(16 * K + 4 * q + g4) * 68 + 16 * J + fr];
                        X = __builtin_amdgcn_mfma_f32_16x16x4f32(av, bv, X, 0, 0, 0); }
                f32x4 Y = (f32x4){0.f, 0.f, 0.f, 0.f};
#pragma unroll
                for (int q = 0; q < 4; ++q) { const float av = Lw[(16 * I + fr) * 68 + 16 * I + 4 * g4 + q]; Y = __builtin_amdgcn_mfma_f32_16x16x4f32(av, X[q], Y, 0, 0, 0); }
                asm volatile("s_waitcnt lgkmcnt(0)" ::: "memory");
#pragma unroll
                for (int r = 0; r < 4; ++r) Lw[(16 * I + 4 * g4 + r) * 68 + 16 * J + fr] = -Y[r];
                asm volatile("s_waitcnt lgkmcnt(0)" ::: "memory");
            }
        float* Sc = (float*)(lds + 139264 + wv * 512);
        Sc[lane] = beta * __expf(g); Sc[64 + lane] = beta;
        asm volatile("s_waitcnt lgkmcnt(0)" ::: "memory");
#pragma unroll
        for (int mat = 0; mat < 2; ++mat) {
            u16* dst = (mat ? ubuf : wbuf) + (size_t)unit * 8192;
            bf16x8 bfr[4][2];
#pragma unroll
            for (int itl = 0; itl < 4; ++itl)
#pragma unroll
                for (int ks = 0; ks < 2; ++ks) { u32x4 fv = (u32x4){0u, 0u, 0u, 0u};
                    if (2 * ks + (g4 >> 1) <= itl) { const float* tp = Lw + (itl * 16 + fr) * 68 + ks * 32 + g4 * 8; const float* sp = Sc + mat * 64 + ks * 32 + g4 * 8;
                        const f32x4 t0 = *(const f32x4*)tp, t1 = *(const f32x4*)(tp + 4), s0 = *(const f32x4*)sp, s1 = *(const f32x4*)(sp + 4);
                        fv.x = pk(t0[0] * s0[0], t0[1] * s0[1]); fv.y = pk(t0[2] * s0[2], t0[3] * s0[3]); fv.z = pk(t1[0] * s1[0], t1[1] * s1[1]); fv.w = pk(t1[2] * s1[2], t1[3] * s1[3]); }
                    bfr[itl][ks] = asbf(fv); }
#pragma unroll
            for (int dt = 0; dt < 8; ++dt) {
                bf16x8 af[2];
#pragma unroll
                for (int ks = 0; ks < 2; ++ks) { u32x4 raw = AF[mat][dt][ks]; if (dir) raw = rev8(raw); af[ks] = asbf(raw); }
#pragma unroll
                for (int itl = 0; itl < 4; ++itl) { f32x4 c = (f32x4){0.f, 0.f, 0.f, 0.f};
#pragma unroll
                    for (int ks = 0; ks < 2; ++ks) c = mfma16(af[ks], bfr[itl][ks], c);
                    u32x2 w2; w2.x = pk(c[0], c[1]); w2.y = pk(c[2], c[3]);
                    *(u32x2*)(dst + (itl * 16 + fr) * 128 + dt * 16 + 4 * g4) = w2; }
            }
        }
        asm volatile("s_waitcnt lgkmcnt(0)" ::: "memory");
    }
    const u16* Bm = (const u16*)(p.ws + U + U / 2); const u16* Cm = (const u16*)((unsigned char*)p.out + 3 * U); u16* CBp = (u16*)((unsigned char*)p.out + 3 * U + U / 2);
    for (int unit = blockIdx.x; unit < 1536; unit += gridDim.x) {
        const int fr = lane0 & 15, g4 = lane0 >> 4;
        const int g = unit & 1, ck = unit >> 1; const int Rc = ck * 128;
        bf16x8 cf[4];
#pragma unroll
        for (int ks = 0; ks < 4; ++ks) cf[ks] = *(const bf16x8*)(Cm + (size_t)(Rc + wv * 16 + fr) * 256 + g * 128 + ks * 32 + g4 * 8);
#pragma unroll 2
        for (int st = 0; st < 8; ++st) { f32x4 c = (f32x4){0.f, 0.f, 0.f, 0.f};
#pragma unroll
            for (int ks = 0; ks < 4; ++ks) { const bf16x8 bfg = *(const bf16x8*)(Bm + (size_t)(Rc + st * 16 + fr) * 256 + g * 128 + ks * 32 + g4 * 8); c = mfma16(bfg, cf[ks], c); }
            u32x2 w2; w2.x = pk(c[0], c[1]); w2.y = pk(c[2], c[3]);
            *(u32x2*)(CBp + (size_t)unit * 16384 + (wv * 16 + fr) * 128 + st * 16 + 4 * g4) = w2; }
    }
}

constexpr int DN_BUFB = 80384;
__device__ void dn_scan_item(const P& p, unsigned char* lds, int s, int h, int dir) {
    int T, row0; seq_info(s, T, row0); const int NC = T / 64;
    const int tid0 = threadIdx.x; const int wv0 = __builtin_amdgcn_readfirstlane(tid0 >> 6);
    const u16* Cq = (const u16*)(p.ws + 9 * U); const u16* kT = (const u16*)((unsigned char*)p.out + 2 * U);
    const u16* wbuf = (const u16*)(p.ws + 2 * U); const u16* attn = (const u16*)(p.ws + 4 * U); u16* ubuf = (u16*)(p.ws + 5 * U);
    const float* gcum = (const float*)(p.ws + OFF_GCUM);
#define DN_UNIT(NV) ((size_t)((((row0 >> 6) + (dir ? NC - 1 - (NV) : (NV))) * 4 + h) * 2 + dir))
    if (wv0 >= 4) {
        const int ts0 = tid0 - 256;
        u32x4 pw[4], pu[4], pq[4], pk2[4], pa[2]; float pg = 0.f;
        unsigned vo_wu[4], vo_q[4], vo_k[4], vo_a[2]; const unsigned vo_g = (unsigned)ts0 * 4u;
#pragma unroll
        for (int k = 0; k < 4; ++k) { const int pc = ts0 + k * 256; const int i = pc >> 4, c8 = pc & 15; const int d = pc >> 3, j8 = pc & 7;
            vo_wu[k] = (unsigned)pc * 16u; vo_q[k] = (unsigned)((dir ? 63 - i : i) * 512 + c8 * 8) * 2u; vo_k[k] = (unsigned)(d * 64 + (dir ? 56 - j8 * 8 : j8 * 8)) * 2u; }
#pragma unroll
        for (int k = 0; k < 2; ++k) vo_a[k] = (unsigned)(ts0 + k * 256) * 16u;
#define DN_ISSUE(NV) do { const int nreal_ = dir ? NC - 1 - (NV) : (NV); const size_t unit_ = DN_UNIT(NV); const int Rc_ = row0 + nreal_ * 64; \
            const char* bw_ = (const char*)(wbuf + unit_ * 8192); const char* bu_ = (const char*)(ubuf + unit_ * 8192); const char* bq_ = (const char*)(Cq + (size_t)Rc_ * 512 + h * 128); \
            const char* bk_ = (const char*)(kT + ((size_t)((row0 >> 6) + nreal_) * 512 + h * 128) * 64); const char* ba_ = (const char*)(attn + unit_ * 4096); const char* bg_ = (const char*)(gcum + unit_ * 128); \
            _Pragma("unroll") for (int k = 0; k < 4; ++k) { pw[k] = *(const u32x4*)(bw_ + vo_wu[k]); pu[k] = *(const u32x4*)(bu_ + vo_wu[k]); pq[k] = *(const u32x4*)(bq_ + vo_q[k]); pk2[k] = *(const u32x4*)(bk_ + vo_k[k]); } \
            _Pragma("unroll") for (int k = 0; k < 2; ++k) pa[k] = *(const u32x4*)(ba_ + vo_a[k]); \
            if (ts0 < 128) pg = *(const float*)(bg_ + vo_g); } while (0)
#define DN_COMMIT(BUF, TS) do { u16* Lw_ = (u16*)(lds + (BUF) * DN_BUFB); u16* Lq = Lw_ + 64 * 136; u16* Lu = Lq + 64 * 136; u16* Lk = Lu + 64 * 136; u16* La = Lk + 128 * 72; float* Lg = (float*)(La + 64 * 72); \
            _Pragma("unroll") for (int k = 0; k < 4; ++k) { const int pc = (TS) + k * 256; const int i = pc >> 4, c8 = pc & 15; \
                *(u32x4*)(Lw_ + i * 136 + c8 * 8) = pw[k]; *(u32x4*)(Lu + i * 136 + c8 * 8) = pu[k]; *(u32x4*)(Lq + i * 136 + c8 * 8) = pq[k]; \
                const int d = pc >> 3, j8 = pc & 7; *(u32x4*)(Lk + d * 72 + j8 * 8) = dir ? rev8(pk2[k]) : pk2[k]; } \
            _Pragma("unroll") for (int k = 0; k < 2; ++k) { const int pc = (TS) + k * 256; *(u32x4*)(La + (pc >> 3) * 72 + (pc & 7) * 8) = pa[k]; } \
            if ((TS) < 128) Lg[(TS)] = pg; } while (0)
#define DN_FLUSH(BUF, UNIT, TS) do { const u16* Lu = (const u16*)(lds + (BUF) * DN_BUFB) + 2 * 64 * 136; \
            _Pragma("unroll") for (int k = 0; k < 4; ++k) { const int pc = (TS) + k * 256; const int i = pc >> 4, c8 = pc & 15; *(u32x4*)(ubuf + (UNIT) * 8192 + pc * 8) = *(const u32x4*)(Lu + i * 136 + c8 * 8); } } while (0)
        DN_ISSUE(0); DN_COMMIT(0, ts0);
        if (NC > 1) DN_ISSUE(1);
        __syncthreads();
        for (int nv = 0; nv < NC; ++nv) {
            int ts = ts0; asm volatile("" : "+v"(ts));
            const int ob = (nv + 1) & 1;
            if (nv >= 1) DN_FLUSH(ob, DN_UNIT(nv - 1), ts);
            if (nv + 1 < NC) DN_COMMIT(ob, ts);
            if (nv + 2 < NC) DN_ISSUE(nv + 2);
            __syncthreads();
        }
        DN_FLUSH((NC - 1) & 1, DN_UNIT(NC - 1), ts0);
#undef DN_ISSUE
#undef DN_COMMIT
#undef DN_FLUSH
    } else {
        f32x4 S[2][8];
#pragma unroll
        for (int c = 0; c < 2; ++c)
#pragma unroll
            for (int i = 0; i < 8; ++i) S[c][i] = (f32x4){0.f, 0.f, 0.f, 0.f};
        __syncthreads();
        for (int nv = 0; nv < NC; ++nv) {
            int tid = tid0; asm volatile("" : "+v"(tid));
            const int lane = tid & 63, wv = __builtin_amdgcn_readfirstlane(tid >> 6), fr = lane & 15, g4 = lane >> 4; const int e = wv * 32 + fr;
            u16* Lw_ = (u16*)(lds + (nv & 1) * DN_BUFB); u16* Lq = Lw_ + 64 * 136; u16* Lu = Lq + 64 * 136; u16* Lk = Lu + 64 * 136; u16* La = Lk + 128 * 72; const float* Lg = (const float*)(La + 64 * 72);
            bf16x8 Sb[2][4];
#pragma unroll
            for (int c = 0; c < 2; ++c)
#pragma unroll
                for (int Q = 0; Q < 4; ++Q) Sb[c][Q] = packB(S[c][2 * Q], S[c][2 * Q + 1]);
            f32x4 vn[2][4], oa[2][4];
#pragma unroll
            for (int it = 0; it < 4; ++it) {
                f32x4 a1[2], a2[2];
#pragma unroll
                for (int c = 0; c < 2; ++c) { a1[c] = (f32x4){0.f, 0.f, 0.f, 0.f}; a2[c] = (f32x4){0.f, 0.f, 0.f, 0.f}; }
#pragma unroll
                for (int Q = 0; Q < 4; ++Q) { const bf16x8 Aw = ldA2(Lw_ + (it * 16 + fr) * 136 + 32 * Q + 4 * g4), Aq = ldA2(Lq + (it * 16 + fr) * 136 + 32 * Q + 4 * g4);
#pragma unroll
                    for (int c = 0; c < 2; ++c) { a1[c] = mfma16(Aw, Sb[c][Q], a1[c]); a2[c] = mfma16(Aq, Sb[c][Q], a2[c]); } }
#pragma unroll
                for (int r = 0; r < 4; ++r) { const int i = it * 16 + 4 * g4 + r; const float eg = Lg[i];
#pragma unroll
                    for (int c = 0; c < 2; ++c) { vn[c][it][r] = bf2f(Lu[i * 136 + e + 16 * c]) - a1[c][r]; oa[c][it][r] = a2[c][r] * eg; } }
            }
            const float egl = Lg[63];
            bf16x8 Vb[2][2], Vs[2][2];
#pragma unroll
            for (int Qj = 0; Qj < 2; ++Qj) { float d0[4], d1[4];
#pragma unroll
                for (int r = 0; r < 4; ++r) { d0[r] = Lg[64 + (2 * Qj) * 16 + 4 * g4 + r]; d1[r] = Lg[64 + (2 * Qj + 1) * 16 + 4 * g4 + r]; }
#pragma unroll
                for (int c = 0; c < 2; ++c) { Vb[c][Qj] = packB(vn[c][2 * Qj], vn[c][2 * Qj + 1]); f32x4 s0, s1;
#pragma unroll
                    for (int r = 0; r < 4; ++r) { s0[r] = vn[c][2 * Qj][r] * d0[r]; s1[r] = vn[c][2 * Qj + 1][r] * d1[r]; }
                    Vs[c][Qj] = packB(s0, s1); } }
#pragma unroll
            for (int it = 0; it < 4; ++it) {
#pragma unroll
                for (int Qj = 0; Qj < 2; ++Qj) { const bf16x8 Aa = ldA2(La + (it * 16 + fr) * 72 + 32 * Qj + 4 * g4);
#pragma unroll
                    for (int c = 0; c < 2; ++c) oa[c][it] = mfma16(Aa, Vb[c][Qj], oa[c][it]); }
#pragma unroll
                for (int c = 0; c < 2; ++c)
#pragma unroll
                    for (int r = 0; r < 4; ++r) Lu[(it * 16 + 4 * g4 + r) * 136 + e + 16 * c] = f2bf(oa[c][it][r]);
            }
#pragma unroll
            for (int dt = 0; dt < 8; ++dt) {
#pragma unroll
                for (int c = 0; c < 2; ++c) S[c][dt] *= egl;
#pragma unroll
                for (int Qj = 0; Qj < 2; ++Qj) { const bf16x8 Ak = ldA2(Lk + (dt * 16 + fr) * 72 + 32 * Qj + 4 * g4);
#pragma unroll
                    for (int c = 0; c < 2; ++c) S[c][dt] = mfma16(Ak, Vs[c][Qj], S[c][dt]); }
            }
            __syncthreads();
        }
    }
#undef DN_UNIT
}

__device__ void ssd_item(const P& p, unsigned char* lds, int s, int hh, int dir) {
    int T, row0; seq_info(s, T, row0); const int NC = T / 128; const int gg = hh >> 2;
    const int tid0 = threadIdx.x;
    const u16* xT = (const u16*)(p.ws); const u16* BmT = (const u16*)(p.ws + U); const u16* Cm = (const u16*)((unsigned char*)p.out + 3 * U); const u16* CBp = (const u16*)((unsigned char*)p.out + 3 * U + U / 2);
    const float* small = (const float*)(p.ws + OFF_SMALL);
    u16* ybuf = (u16*)((unsigned char*)p.out + (size_t)dir * U);
    u16* LM = (u16*)lds; u16* LC = LM + 128 * 136; u16* LB = LC + 128 * 136; u16* LX = LB + 128 * 136; float* Wbase = (float*)(LX + 64 * 136);
    const float A = -__expf(p.ssm_A_log[dir * 8 + hh]); const float dtb = p.ssm_dt_bias[dir * 8 + hh]; const float Dh = p.ssm_D[hh];
    f32x4 S[8];
#pragma unroll
    for (int i = 0; i < 8; ++i) S[i] = (f32x4){0.f, 0.f, 0.f, 0.f};
    u32x4 pcm[4], pbm[4], pxx[2], pcbd, pcbo[2]; float pd0 = 0.f, pd1 = 0.f;
#define SSD_ISSUE(CV, TID) do { const int creal_ = dir ? NC - 1 - (CV) : (CV); const int Rc_ = row0 + creal_ * 128; const int ln_ = (TID) & 63; \
        pd0 = small[(size_t)(Rc_ + (dir ? 127 - ln_ : ln_)) * 32 + 16 + dir * 8 + hh]; pd1 = small[(size_t)(Rc_ + (dir ? 63 - ln_ : 64 + ln_)) * 32 + 16 + dir * 8 + hh]; \
        _Pragma("unroll") for (int k = 0; k < 4; ++k) { const int pc = (TID) + k * 512; const int l = pc >> 4, c8 = pc & 15; const size_t Rr = (size_t)(Rc_ + (dir ? 127 - l : l)); \
            pcm[k] = *(const u32x4*)(Cm + Rr * 256 + gg * 128 + c8 * 8); const int loff = dir ? 120 - c8 * 8 : c8 * 8; \
            pbm[k] = *(const u32x4*)(BmT + ((size_t)((row0 >> 7) + creal_) * 256 + gg * 128 + l) * 128 + loff); } \
        _Pragma("unroll") for (int k = 0; k < 2; ++k) { const int pc = (TID) + k * 512; const int pp = pc >> 4, l8 = pc & 15; const int loff = dir ? 120 - l8 * 8 : l8 * 8; \
            pxx[k] = *(const u32x4*)(xT + ((size_t)((row0 >> 7) + creal_) * 512 + hh * 64 + pp) * 128 + loff); } \
        { const u16* cbt = CBp + (size_t)((Rc_ >> 7) * 2 + gg) * 16384; \
          { const int ab = (TID) >> 7, l = 32 * ab + (((TID) >> 2) & 31), s0 = 32 * ab + 8 * ((TID) & 3); pcbd = (u32x4){0u, 0u, 0u, 0u}; \
            if (s0 <= l) pcbd = *(const u32x4*)(cbt + (dir ? 127 - l : l) * 128 + (dir ? 120 - s0 : s0)); } \
          _Pragma("unroll") for (int k = 0; k < 2; ++k) { const int q = (TID) + k * 512; pcbo[k] = (u32x4){0u, 0u, 0u, 0u}; \
            if (q < 768) { const int blk = q >> 7; const int ab = blk >= 3 ? 3 : (blk >= 1 ? 2 : 1); const int kb = blk - (ab == 3 ? 3 : (ab == 2 ? 1 : 0)); \
              const int l = 32 * ab + ((q >> 2) & 31), s0 = 32 * kb + 8 * (q & 3); pcbo[k] = *(const u32x4*)(cbt + (dir ? 127 - l : l) * 128 + (dir ? 120 - s0 : s0)); } } } } while (0)
    SSD_ISSUE(0, tid0);
    for (int cv = 0; cv < NC; ++cv) {
        int tid = tid0; asm volatile("" : "+v"(tid));
        const int lane = tid & 63, wv = __builtin_amdgcn_readfirstlane(tid >> 6), fr = lane & 15, g4 = lane >> 4;
        const int pb = wv & 3; const int pcol = pb * 16 + fr;
        float* Wdt = Wbase + wv * 768; float* Wacs = Wdt + 128; float* Wf = Wacs + 128; float* We = Wf + 128; float* Wx = We + 128; float* Wr = Wx + 128; float D1, D2, D3;
        const int creal = dir ? NC - 1 - cv : cv; const int Rc = row0 + creal * 128;
        __syncthreads();
        { const float dt0 = softplus_f(pd0 + dtb), dt1 = softplus_f(pd1 + dtb); float a0 = dt0 * A, a1 = dt1 * A;
#pragma unroll
          for (int o = 1; o < 64; o <<= 1) { const float t0 = __shfl_up(a0, o), t1 = __shfl_up(a1, o); if (lane >= o) { a0 += t0; a1 += t1; } }
          a1 += __shfl(a0, 63); const float a127 = __shfl(a1, 63);
          Wdt[lane] = dt0; Wdt[64 + lane] = dt1; Wacs[lane] = a0; Wacs[64 + lane] = a1; Wf[lane] = __expf(a127 - a0) * dt0; Wf[64 + lane] = __expf(a127 - a1) * dt1;
          We[lane] = __expf(__shfl(a0, lane | 7) - a0) * dt0; We[64 + lane] = __expf(__shfl(a1, lane | 7) - a1) * dt1;
          Wx[lane] = __expf(__shfl(a0, lane | 31) - a0) * dt0; Wx[64 + lane] = __expf(__shfl(a1, lane | 31) - a1) * dt1;
          const float c31 = __shfl(a0, 31), c63 = __shfl(a0, 63), c95 = __shfl(a1, 31);
          Wr[lane] = lane < 32 ? 1.f : __expf(a0 - c31); Wr[64 + lane] = __expf(a1 - (lane < 32 ? c63 : c95));
          D1 = __expf(c63 - c31); D2 = __expf(c95 - c63); D3 = __expf(a127 - c95); }
        asm volatile("s_waitcnt lgkmcnt(0)" ::: "memory");
#pragma unroll
        for (int k = 0; k < 4; ++k) { const int pc = tid + k * 512; const int l = pc >> 4, c8 = pc & 15;
            *(u32x4*)(LC + l * 136 + c8 * 8) = pcm[k]; *(u32x4*)(LB + l * 136 + c8 * 8) = dir ? rev8(pbm[k]) : pbm[k]; }
#pragma unroll
        for (int k = 0; k < 2; ++k) { const int pc = tid + k * 512; const int pp = pc >> 4, l8 = pc & 15; *(u32x4*)(LX + pp * 136 + l8 * 8) = dir ? rev8(pxx[k]) : pxx[k]; }
        { const int ab = tid >> 7, l = 32 * ab + ((tid >> 2) & 31), s0 = 32 * ab + 8 * (tid & 3); const float al = Wacs[l]; u32x4 o4 = (u32x4){0u, 0u, 0u, 0u};
          if (s0 <= l) { const u32x4 raw = dir ? rev8(pcbd) : pcbd;
              float v[8]; v[0] = blo(raw.x); v[1] = bhi(raw.x); v[2] = blo(raw.y); v[3] = bhi(raw.y); v[4] = blo(raw.z); v[5] = bhi(raw.z); v[6] = blo(raw.w); v[7] = bhi(raw.w);
              if (s0 + 7 <= l) { const float fgrp = __expf(fminf(al - Wacs[s0 + 7], 0.f)); const f32x4 e0 = *(const f32x4*)(We + s0), e1 = *(const f32x4*)(We + s0 + 4);
#pragma unroll
                  for (int e8 = 0; e8 < 4; ++e8) { v[e8] *= fgrp * e0[e8]; v[4 + e8] *= fgrp * e1[e8]; } }
              else {
#pragma unroll
                  for (int e8 = 0; e8 < 8; ++e8) { const int sx = s0 + e8; v[e8] = (sx <= l) ? v[e8] * __expf(fminf(al - Wacs[sx], 0.f)) * Wdt[sx] : 0.f; } }
              o4.x = pk(v[0], v[1]); o4.y = pk(v[2], v[3]); o4.z = pk(v[4], v[5]); o4.w = pk(v[6], v[7]); }
          *(u32x4*)(LM + l * 136 + s0) = o4; }
#pragma unroll
        for (int k = 0; k < 2; ++k) { const int q = tid + k * 512;
            if (q < 768) { const int blk = q >> 7; const int ab = blk >= 3 ? 3 : (blk >= 1 ? 2 : 1); const int kb = blk - (ab == 3 ? 3 : (ab == 2 ? 1 : 0));
                const int l = 32 * ab + ((q >> 2) & 31), s0 = 32 * kb + 8 * (q & 3); *(u32x4*)(LM + l * 136 + s0) = dir ? rev8(pcbo[k]) : pcbo[k]; } }
        __syncthreads();
        if (cv + 1 < NC) SSD_ISSUE(cv + 1, tid);
        if (wv < 4) {
        bf16x8 Sb[4];
#pragma unroll
        for (int Q = 0; Q < 4; ++Q) Sb[Q] = packB(S[2 * Q], S[2 * Q + 1]);
        const float e127 = __expf(Wacs[127]);
        bf16x8 xf[4];
#pragma unroll
        for (int ks = 0; ks < 4; ++ks) xf[ks] = *(const bf16x8*)(LX + pcol * 136 + ks * 32 + g4 * 8);
        bf16x8 xe[3];
#pragma unroll
        for (int ks = 0; ks < 3; ++ks) { const u32x4 raw = __builtin_bit_cast(u32x4, xf[ks]); const float* fp = Wx + ks * 32 + g4 * 8;
            u32x4 sc; sc.x = pk(blo(raw.x) * fp[0], bhi(raw.x) * fp[1]); sc.y = pk(blo(raw.y) * fp[2], bhi(raw.y) * fp[3]); sc.z = pk(blo(raw.z) * fp[4], bhi(raw.z) * fp[5]); sc.w = pk(blo(raw.w) * fp[6], bhi(raw.w) * fp[7]);
            xe[ks] = asbf(sc); }
#pragma unroll
        for (int lt = 0; lt < 8; ++lt) {
            const int lbase = lt * 16;
            f32x4 yo = (f32x4){0.f, 0.f, 0.f, 0.f};
#pragma unroll
            for (int Q = 0; Q < 4; ++Q) { const bf16x8 Ac = ldA2(LC + (lbase + fr) * 136 + 32 * Q + 4 * g4); yo = mfma16(Ac, Sb[Q], yo); }
#pragma unroll
            for (int r = 0; r < 4; ++r) yo[r] *= __expf(Wacs[lbase + 4 * g4 + r]);
            const int ab = lbase >> 5;
            if (ab > 0) { f32x4 acc = (f32x4){0.f, 0.f, 0.f, 0.f};
#pragma unroll
                for (int ks = 0; ks < 3; ++ks) if (ks < ab) { if (ks == 1) acc *= D1; if (ks == 2) acc *= D2;
                    const bf16x8 Ar = *(const bf16x8*)(LM + (lbase + fr) * 136 + ks * 32 + g4 * 8); acc = mfma16(Ar, xe[ks], acc); }
#pragma unroll
                for (int r = 0; r < 4; ++r) yo[r] += Wr[lbase + 4 * g4 + r] * acc[r]; }
            { const bf16x8 Am = *(const bf16x8*)(LM + (lbase + fr) * 136 + ab * 32 + g4 * 8); yo = mfma16(Am, xf[ab], yo); }
            if (dir == 0) { const u32x2 xx = *(const u32x2*)(LX + pcol * 136 + lbase + 4 * g4); yo[0] += Dh * blo(xx.x); yo[1] += Dh * bhi(xx.x); yo[2] += Dh * blo(xx.y); yo[3] += Dh * bhi(xx.y); }
#pragma unroll
            for (int r = 0; r < 4; ++r) { const int l = lbase + 4 * g4 + r; const size_t Rr = (size_t)(Rc + (dir ? 127 - l : l)); ybuf[Rr * 512 + hh * 64 + pcol] = f2bf(yo[r]); }
        }
        bf16x8 xsf[4];
#pragma unroll
        for (int ks = 0; ks < 4; ++ks) { const u32x4 raw = __builtin_bit_cast(u32x4, xf[ks]); const float* fp = Wf + ks * 32 + g4 * 8;
            u32x4 sc; sc.x = pk(blo(raw.x) * fp[0], bhi(raw.x) * fp[1]); sc.y = pk(blo(raw.y) * fp[2], bhi(raw.y) * fp[3]); sc.z = pk(blo(raw.z) * fp[4], bhi(raw.z) * fp[5]); sc.w = pk(blo(raw.w) * fp[6], bhi(raw.w) * fp[7]);
            xsf[ks] = asbf(sc); }
#pragma unroll
        for (int nt = 0; nt < 8; ++nt) { S[nt] *= e127;
#pragma unroll
            for (int ks = 0; ks < 4; ++ks) { const bf16x8 Ab = *(const bf16x8*)(LB + (nt * 16 + fr) * 136 + ks * 32 + g4 * 8); S[nt] = mfma16(Ab, xsf[ks], S[nt]); }
            }
        }
    }
#undef SSD_ISSUE
}

__device__ void phase_scan(const P& p, unsigned char* lds) {
    const int x = blockIdx.x & 7;
    unsigned* cnt = (unsigned*)(p.ws + OFF_CNT) + x;
    int* slot = (int*)(lds + LDS_BYTES - 16);
    for (;;) {
        __syncthreads();
        if (threadIdx.x == 0) *slot = (int)atomicAdd(cnt, 1u);
        __syncthreads();
        const int q = __builtin_amdgcn_readfirstlane(*slot);
        if (q >= 60) break;
        int isdn, sq, hq, dq;
        if (q < 4) { const int dl = x * 4 + q; isdn = 1; sq = dl >> 3; hq = (dl & 7) >> 1; dq = dl & 1; }
        else if (q < 12) { const int bl = x * 2 + ((q - 4) >> 2); isdn = 0; sq = bl >> 2; hq = ((bl >> 1) & 1) * 4 + ((q - 4) & 3); dq = bl & 1; }
        else if (q < 28) { const int ds = x * 16 + (q - 12); isdn = 1; sq = 4 + (ds >> 3); hq = (ds & 7) >> 1; dq = ds & 1; }
        else { const int bs = x * 8 + ((q - 28) >> 2); isdn = 0; sq = 4 + (bs >> 2); hq = ((bs >> 1) & 1) * 4 + ((q - 28) & 3); dq = bs & 1; }
        if (isdn) dn_scan_item(p, lds, sq, hq, dq);
        else ssd_item(p, lds, sq, hq, dq);
    }
    unsigned* cnt2 = (unsigned*)(p.ws + OFF_CNT) + 32;
    for (;;) {
        __syncthreads();
        if (threadIdx.x == 0) *slot = (int)atomicAdd(cnt2, 1u);
        __syncthreads();
        const int t = __builtin_amdgcn_readfirstlane(*slot);
        if (t >= 2368) break;
        weight_tile(p, lds, 960 + t);
    }
}

__device__ void phase_combine(const P& p) {
    const int tid = threadIdx.x;
    const u16* obuf = (const u16*)(p.ws + 5 * U); const u16* yf = (const u16*)((unsigned char*)p.out); const u16* yb = (const u16*)((unsigned char*)p.out + U);
    const u16* dnz = (const u16*)(p.ws + 8 * U); const u16* ssmz = (const u16*)(p.ws + 7 * U); u16* mix = (u16*)(p.ws + 2 * U);
    const int c8 = tid & 127; const bool isdn = c8 < 64;
    for (int rg = blockIdx.x; rg < NTOK / 16; rg += gridDim.x) {
        u32x4 la[4], lb[4], lz[4];
#pragma unroll
        for (int u = 0; u < 4; ++u) { const int R = rg * 16 + u * 4 + (tid >> 7);
            if (isdn) { const int h = c8 >> 4, e0 = (c8 & 15) * 8; const int chunk = R >> 6, i0 = R & 63;
                la[u] = *(const u32x4*)(obuf + (size_t)((chunk * 4 + h) * 2 + 0) * 8192 + i0 * 128 + e0);
                lb[u] = *(const u32x4*)(obuf + (size_t)((chunk * 4 + h) * 2 + 1) * 8192 + (63 - i0) * 128 + e0);
                lz[u] = *(const u32x4*)(dnz + (size_t)R * 512 + h * 128 + e0); }
            else { const int c = (c8 - 64) * 8; la[u] = *(const u32x4*)(yf + (size_t)R * 512 + c); lb[u] = *(const u32x4*)(yb + (size_t)R * 512 + c); lz[u] = *(const u32x4*)(ssmz + (size_t)R * 512 + c); } }
#pragma unroll
        for (int u = 0; u < 4; ++u) { const int R = rg * 16 + u * 4 + (tid >> 7);
            const u32x4 a = la[u], b = lb[u], z = lz[u];
            float v[8], zz[8];
            v[0] = blo(a.x) + blo(b.x); v[1] = bhi(a.x) + bhi(b.x); v[2] = blo(a.y) + blo(b.y); v[3] = bhi(a.y) + bhi(b.y);
            v[4] = blo(a.z) + blo(b.z); v[5] = bhi(a.z) + bhi(b.z); v[6] = blo(a.w) + blo(b.w); v[7] = bhi(a.w) + bhi(b.w);
            zz[0] = blo(z.x); zz[1] = bhi(z.x); zz[2] = blo(z.y); zz[3] = bhi(z.y); zz[4] = blo(z.z); zz[5] = bhi(z.z); zz[6] = blo(z.w); zz[7] = bhi(z.w);
            u16* dstp;
            if (isdn) { const int h = c8 >> 4, e0 = (c8 & 15) * 8;
                float ss = 0.f;
#pragma unroll
                for (int j = 0; j < 8; ++j) ss += v[j] * v[j];
                ss += __shfl_xor(ss, 1); ss += __shfl_xor(ss, 2); ss += __shfl_xor(ss, 4); ss += __shfl_xor(ss, 8);
                const float r = rsqrtf(ss * (1.f / 128.f) + 1e-6f);
#pragma unroll
                for (int j = 0; j < 8; ++j) v[j] = v[j] * r * p.dn_norm_w[e0 + j] * silu_f(zz[j]);
                dstp = mix + (size_t)R * 1024 + h * 128 + e0;
            } else { const int c = (c8 - 64) * 8;
                float ss = 0.f;
#pragma unroll
                for (int j = 0; j < 8; ++j) { v[j] *= silu_f(zz[j]); ss += v[j] * v[j]; }
                ss += __shfl_xor(ss, 1); ss += __shfl_xor(ss, 2); ss += __shfl_xor(ss, 4); ss += __shfl_xor(ss, 8); ss += __shfl_xor(ss, 16);
                const float r = rsqrtf(ss * (1.f / 256.f) + 1e-6f);
#pragma unroll
                for (int j = 0; j < 8; ++j) v[j] = v[j] * r * p.ssm_norm_w[c + j];
                dstp = mix + (size_t)R * 1024 + 512 + c; }
            u32x4 o; o.x = pk(v[0], v[1]); o.y = pk(v[2], v[3]); o.z = pk(v[4], v[5]); o.w = pk(v[6], v[7]);
            *(u32x4*)dstp = o; }
    }
}

__device__ void phase_ln(const P& p, const u16* src, const float* gam, const float* bet, u16* h2, u16* x1b) {
    const int tid = threadIdx.x, lane = tid & 63, wv = __builtin_amdgcn_readfirstlane(tid >> 6); const float* mod = (const float*)(p.ws + OFF_MOD);
    for (int R0 = (blockIdx.x * 8 + wv) * 4; R0 < NTOK; R0 += gridDim.x * 32) {
        u32x4 wl[4][2];
#pragma unroll
        for (int rr = 0; rr < 4; ++rr)
#pragma unroll
            for (int k = 0; k < 2; ++k) wl[rr][k] = *(const u32x4*)(src + (size_t)(R0 + rr) * 1024 + k * 512 + lane * 8);
        const int s = seq_of_row(R0);
#pragma unroll
        for (int rr = 0; rr < 4; ++rr) {
            const int R = R0 + rr;
            float v[16]; float sum = 0.f;
#pragma unroll
            for (int k = 0; k < 2; ++k) { const u32x4 w = wl[rr][k];
                v[k * 8 + 0] = blo(w.x); v[k * 8 + 1] = bhi(w.x); v[k * 8 + 2] = blo(w.y); v[k * 8 + 3] = bhi(w.y); v[k * 8 + 4] = blo(w.z); v[k * 8 + 5] = bhi(w.z); v[k * 8 + 6] = blo(w.w); v[k * 8 + 7] = bhi(w.w); }
#pragma unroll
            for (int j = 0; j < 16; ++j) sum += v[j];
#pragma unroll
            for (int o = 32; o >= 1; o >>= 1) sum += __shfl_xor(sum, o);
            const float mu = sum * (1.f / 1024.f); float q = 0.f;
#pragma unroll
            for (int j = 0; j < 16; ++j) { const float d = v[j] - mu; q += d * d; }
#pragma unroll
            for (int o = 32; o >= 1; o >>= 1) q += __shfl_xor(q, o);
            const float rstd = rsqrtf(q * (1.f / 1024.f) + 1e-5f);
            float* rp = p.out + (size_t)R * 1024;
#pragma unroll
            for (int k = 0; k < 2; ++k) { const int c = k * 512 + lane * 8; float o[8];
#pragma unroll
                for (int hq = 0; hq < 2; ++hq) { const f32x4 gv = *(const f32x4*)(gam + c + hq * 4), bv = *(const f32x4*)(bet + c + hq * 4); f32x4 ov;
#pragma unroll
                    for (int j = 0; j < 4; ++j) { ov[j] = (v[k * 8 + hq * 4 + j] - mu) * rstd * gv[j] + bv[j]; o[hq * 4 + j] = ov[j]; }
                    if (!x1b) *(f32x4*)(rp + c + hq * 4) = ov; }
                if (x1b) { u32x4 w; w.x = pk(o[0], o[1]); w.y = pk(o[2], o[3]); w.z = pk(o[4], o[5]); w.w = pk(o[6], o[7]); *(u32x4*)(x1b + (size_t)R * 1024 + c) = w; }
                if (h2) { const float* ms = mod + s * 6144 + c; float hv[8];
#pragma unroll
                    for (int hq = 0; hq < 2; ++hq) { const f32x4 sh = *(const f32x4*)(ms + 3072 + hq * 4), sc = *(const f32x4*)(ms + 4096 + hq * 4);
#pragma unroll
                        for (int j = 0; j < 4; ++j) hv[hq * 4 + j] = o[hq * 4 + j] * (1.f + sc[j]) + sh[j]; }
                    u32x4 w; w.x = pk(hv[0], hv[1]); w.y = pk(hv[2], hv[3]); w.z = pk(hv[4], hv[5]); w.w = pk(hv[6], hv[7]);
                    *(u32x4*)(h2 + (size_t)R * 1024 + c) = w; } }
        }
    }
}

__global__ void __launch_bounds__(512, 2) mega(P p, int ph_lo, int ph_hi, int coop) {
    extern __shared__ __attribute__((aligned(16))) unsigned char lds[];
    cg::grid_group grid = cg::this_grid();
    const int G = gridDim.x, bx = blockIdx.x;
    float* mod = (float*)(p.ws + OFF_MOD);
#ifndef PHASE_MASK
#define PHASE_MASK 0xfff
#endif
#define IN(k) (((PHASE_MASK >> (k)) & 1) && ph_lo <= (k) && (k) < ph_hi)
#define SEAM(k) do { if (coop && (k) + 1 < ph_hi) grid.sync(); } while (0)
    if (IN(0)) { phase_prep(p, lds); SEAM(0); }
    if (IN(1)) { __syncthreads(); phase_h1(p, lds); SEAM(1); }
    if (IN(2)) { __syncthreads();
        pg8::Gemm g{(const u16*)p.ws, (const u16*)(p.ws + OFF_WB1), NTOK, 3584, 1024}; pg8::StaticOrder S; S.init(NTOK, 3584, G, bx);
        EpiIn E{(u16*)(p.ws + 2 * U), (u16*)(p.ws + 8 * U), (u16*)(p.ws + 7 * U), (u16*)(p.ws + 5 * U), (float*)(p.ws + OFF_SMALL)};
        pg8::gemm_phase<EpiIn, pg8::StaticOrder>((LAS unsigned char*)lds, g, S, E); SEAM(2); }
    if (IN(3)) { __syncthreads(); phase_conv(p, lds); SEAM(3); }
    if (IN(4)) { __syncthreads(); phase_dnprep(p, lds); SEAM(4); }
    if (IN(5)) { phase_scan(p, lds); SEAM(5); }
    if (IN(6)) { phase_combine(p); SEAM(6); }
    if (IN(7)) { __syncthreads();
        pg8::Gemm g{(const u16*)(p.ws + 2 * U), (const u16*)(p.ws + OFF_WB2), NTOK, 1024, 1024}; pg8::StaticOrder S; S.init(NTOK, 1024, G, bx);
        EpiResT<true, false> E{p.x_prompt, p.x_sample, nullptr, p.out, (u16*)p.ws, mod + 2048};
        pg8::gemm_phase<EpiResT<true, false>, pg8::StaticOrder>((LAS unsigned char*)lds, g, S, E); SEAM(7); }
    if (IN(8)) { phase_ln(p, (const u16*)p.ws, p.ln1_g, p.ln1_b, (u16*)p.ws, (u16*)p.out); SEAM(8); }
    if (IN(9)) { __syncthreads();
        pg8::Gemm g{(const u16*)p.ws, (const u16*)(p.ws + OFF_WB3), NTOK, 5632, 1024}; pg8::StaticOrder S; S.init(NTOK, 5632, G, bx);
        EpiGLU E{(u16*)(p.ws + 2 * U)};
        pg8::gemm_phase<EpiGLU, pg8::StaticOrder>((LAS unsigned char*)lds, g, S, E); SEAM(9); }
    if (IN(10)) { __syncthreads();
        pg8::Gemm g{(const u16*)(p.ws + 2 * U), (const u16*)(p.ws + OFF_WB4), NTOK, 1024, 2816}; pg8::StaticOrder S; S.init(NTOK, 1024, G, bx);
        EpiResT<true, true> E{p.x_prompt, p.x_sample, (const u16*)p.out, p.out, (u16*)p.ws, mod + 5120};
        pg8::gemm_phase<EpiResT<true, true>, pg8::StaticOrder>((LAS unsigned char*)lds, g, S, E); SEAM(10); }
    if (IN(11)) { phase_ln(p, (const u16*)p.ws, p.ln2_g, p.ln2_b, nullptr, nullptr); }
#undef IN
#undef SEAM
}


#ifdef DIAG
constexpr size_t OFF_DIAG = WS_END;
__global__ void diag_cs(const unsigned* buf, size_t nwords, int isbf16, unsigned long long* cs, unsigned* nanf) {
    unsigned long long s = 0; unsigned bad = 0;
    for (size_t i = (size_t)blockIdx.x * blockDim.x + threadIdx.x; i < nwords; i += (size_t)gridDim.x * blockDim.x) { const unsigned w = buf[i]; s += w;
        if (isbf16) { if ((w & 0x7f80u) == 0x7f80u || (w & 0x7f800000u) == 0x7f800000u) bad = 1; } else if ((w & 0x7f800000u) == 0x7f800000u) bad = 1; }
    atomicAdd(cs, s); if (bad) atomicOr(nanf, 1u);
}
__global__ void diag_final(const unsigned long long* cs, const unsigned* nf, float* out, size_t n) {
    int m = 0, nn = 0;
    for (int b = 0; b < 5; ++b) { if (cs[40 + b] != cs[48 + 40 + b]) nn |= 1 << b; if (nf[40 + b] | nf[48 + 40 + b]) m |= 1 << b; }
    float c2 = (float)(10 + m) * 100.f; for (int i = 0; i < nn; ++i) c2 *= 10.f;
    const float c = sqrtf(c2);
    for (size_t i = (size_t)blockIdx.x * blockDim.x + threadIdx.x; i < n; i += (size_t)gridDim.x * blockDim.x) out[i] = c;
}
#endif
#ifndef N_LAUNCH_MODE
#define N_LAUNCH_MODE 1
#endif
extern "C" void kernel_launch(void* const* d_in, const int* in_sizes, int n_in, void* d_out, int out_size, void* d_ws, size_t ws_size, hipStream_t stream) {
    static int grid = 0;
    if (grid == 0) {
        if (n_in != 25 || out_size != NTOK * 1024 || ws_size < WS_END) { fprintf(stderr, "kernel_launch: unexpected shapes (n_in %d out %d ws %zu need %zu)\n", n_in, out_size, ws_size, (size_t)WS_END); grid = -1; return; }
        int dev = 0, cus = 0, per_cu = 0;
        hipGetDevice(&dev); hipDeviceGetAttribute(&cus, hipDeviceAttributeMultiprocessorCount, dev);
        if (hipFuncSetAttribute((const void*)mega, hipFuncAttributeMaxDynamicSharedMemorySize, LDS_BYTES) != hipSuccess) { fprintf(stderr, "kernel_launch: hipFuncSetAttribute failed\n"); grid = -1; return; }
        hipOccupancyMaxActiveBlocksPerMultiprocessor(&per_cu, (const void*)mega, 512, LDS_BYTES);
        if (per_cu < 1) { fprintf(stderr, "kernel_launch: occupancy query says %d blocks/CU\n", per_cu); per_cu = 1; }
        (void)hipGetLastError();
        grid = cus;
    }
    if (grid < 0) return;
    P p{};
    const float** pp = (const float**)&p;
    for (int i = 0; i < 25; ++i) pp[i] = (const float*)d_in[i];
    p.out = (float*)d_out; p.ws = (unsigned char*)d_ws;
#if N_LAUNCH_MODE == 1
    int lo = 0, hi = 12, coop = 1;
    void* args[] = {&p, &lo, &hi, &coop};
    hipError_t e = hipLaunchCooperativeKernel((const void*)mega, dim3(grid), dim3(512), args, LDS_BYTES, stream);
    if (e != hipSuccess) fprintf(stderr, "cooperative launch failed: %s (grid %d)\n", hipGetErrorString(e), grid);
#else
#ifdef DIAG
    unsigned char* ws = (unsigned char*)d_ws; unsigned char* ob = (unsigned char*)d_out;
    unsigned long long* cs = (unsigned long long*)(ws + OFF_DIAG); unsigned* nf = (unsigned*)(ws + OFF_DIAG + 2 * 48 * 8);
    hipMemsetAsync(ws + OFF_DIAG, 0, 2 * 48 * 8 + 2 * 48 * 4, stream);
    for (int run = 0; run < 2; ++run) for (int k = 0; k < 12; ++k) {
        hipLaunchKernelGGL(mega, dim3(grid), dim3(512), LDS_BYTES, stream, p, k, k + 1, 0);
        struct B { unsigned char* p; size_t bytes; int bf; } bl[4] = {{0,0,0},{0,0,0},{0,0,0},{0,0,0}};
        switch (k) {
            case 0: bl[0] = {ws + OFF_WB1, OFF_SMALL - OFF_WB1, 1}; bl[1] = {ws + OFF_MOD, 20 * 6144 * 4, 0}; break;
            case 1: bl[0] = {ws, 2 * U, 1}; break;
            case 2: bl[0] = {ws + 2 * U, 7 * U, 1}; bl[1] = {ws + OFF_SMALL, (size_t)NTOK * 32 * 4, 0}; break;
            case 3: bl[0] = {ws, 2 * U, 1}; bl[1] = {ws + 9 * U, U, 1}; bl[2] = {ob, 3 * U + U / 2, 1}; break;
            case 4: bl[0] = {ws + 2 * U, 5 * U, 1}; bl[1] = {ws + OFF_GCUM, (size_t)12288 * 64 * 4, 0}; bl[2] = {ob + 3 * U + U / 2, U / 2, 1};
                { struct B b5[5] = {{ws + 2 * U, 2 * U, 1}, {ws + 4 * U, U, 1}, {ws + 5 * U, 2 * U, 1}, {ws + OFF_GCUM, (size_t)12288 * 64 * 4, 0}, {ob + 3 * U + U / 2, U / 2, 1}};
                  for (int b = 0; b < 5; ++b) hipLaunchKernelGGL(diag_cs, dim3(2048), dim3(256), 0, stream, (const unsigned*)b5[b].p, b5[b].bytes / 4, b5[b].bf, cs + run * 48 + 40 + b, nf + run * 48 + 40 + b); }
                break;
            case 5: bl[0] = {ws + 5 * U, 2 * U, 1}; bl[1] = {ob, 2 * U, 1}; break;
            case 6: bl[0] = {ws + 2 * U, 2 * U, 1}; break;
            case 7: bl[0] = {ob, 4 * U, 0}; break;
            case 8: bl[0] = {ob, 4 * U, 0}; bl[1] = {ws, 2 * U, 1}; break;
            case 9: bl[0] = {ws + 2 * U, (size_t)NTOK * 2816 * 2, 1}; break;
            case 10: bl[0] = {ob, 4 * U, 0}; break;
            case 11: bl[0] = {ob, 4 * U, 0}; break;
        }
        for (int b = 0; b < 4; ++b) if (bl[b].p) hipLaunchKernelGGL(diag_cs, dim3(2048), dim3(256), 0, stream, (const unsigned*)bl[b].p, bl[b].bytes / 4, bl[b].bf, cs + run * 48 + k * 4 + b, nf + run * 48 + k * 4 + b);
    }
    hipLaunchKernelGGL(diag_final, dim3(2048), dim3(256), 0, stream, (const unsigned long long*)cs, (const unsigned*)nf, (float*)d_out, (size_t)NTOK * 1024);
#else
    for (int k = 0; k < 12; ++k) hipLaunchKernelGGL(mega, dim3(grid), dim3(512), LDS_BYTES, stream, p, k, k + 1, 0);
#endif
#endif
}
```
